# Optimizing an MI355X kernel written in HIP

```python
import math
import jax
import jax.numpy as jnp
from jax import lax
import numpy as np

D_MODEL = 1024
BATCH = 8
SEQ = 2048
DEPTH = 2

F32 = jnp.float32
GRID_W = 64
CTX_LEN = 256
N_MOD = 6
NORM_EPS = 1e-6
ROPE_BASE = 10000.0
CONV_W = 4

LRU_WIDTH = 512
LRU_BLOCKS = 8
LRU_BLOCK = LRU_WIDTH // LRU_BLOCKS
LRU_C = 8.0

HEAD_DIM = 64
WIN_HEADS = 8
WIN_KV_HEADS = 2
WINDOW = 128
WBLK = 128

DIFF_HEADS = 4
DIFF_DH = 64
QBLK = 128

SSD_HEADS = 8
SSD_HEAD_DIM = 64
SSD_INNER = SSD_HEADS * SSD_HEAD_DIM
SSD_GROUPS = 2
SSD_STATE = 128
SSD_CHUNK = 128
SSD_CONV_DIM = SSD_INNER + 2 * SSD_GROUPS * SSD_STATE

N_EXPERTS = 64
N_EXPERT_GROUPS = 8
TOPK_GROUPS = 4
TOP_K = 8
D_EXPERT = 256
D_SHARED = 256
ROUTED_SCALE = 2.5
EXPERT_BLK = 256

N_EVEN = (DEPTH + 1) // 2
N_ODD = DEPTH // 2

AB_Q = WIN_HEADS * HEAD_DIM
AB_KV = WIN_KV_HEADS * HEAD_DIM
AB_CTX_START = LRU_WIDTH + AB_Q
AB_IN = AB_CTX_START + LRU_WIDTH + 2 * AB_KV
AB_SPLITS = (LRU_WIDTH, AB_CTX_START, AB_CTX_START + LRU_WIDTH, AB_CTX_START + LRU_WIDTH + AB_KV)
AB_CTX_SPLITS = (LRU_WIDTH, LRU_WIDTH + AB_KV)
AB_OUT = LRU_WIDTH + AB_Q

CD_QK = DIFF_HEADS * 2 * DIFF_DH
CD_V = DIFF_HEADS * 2 * DIFF_DH
CD_CTX_START = CD_QK + SSD_INNER
CD_IN = CD_CTX_START + CD_QK + CD_V + SSD_CONV_DIM + 2 * SSD_HEADS
CD_SPLITS = (CD_QK, CD_CTX_START, CD_CTX_START + CD_QK, CD_CTX_START + CD_QK + CD_V,
             CD_CTX_START + CD_QK + CD_V + SSD_CONV_DIM)
CD_CTX_SPLITS = (CD_QK, CD_QK + CD_V, CD_QK + CD_V + SSD_CONV_DIM)
CD_OUT = CD_V + SSD_INNER

kernel_name = 'hybrid_diffusion_rglru_swa_diffattn_ssd_moe'


def rms_norm(x, g):
    x32 = x.astype(F32)
    y = x32 * lax.rsqrt(jnp.mean(x32 * x32, axis=-1, keepdims=True) + NORM_EPS)
    return (y * g.astype(F32)).astype(x.dtype)


def modulate(h, shift, scale):
    return h * (1.0 + scale) + shift


def axial_rope_tables(n_tok, dim, dtype):
    rows = n_tok // GRID_W
    row = jnp.repeat(jnp.arange(rows), GRID_W).astype(F32)
    col = jnp.tile(jnp.arange(GRID_W), rows).astype(F32)
    n = dim // 4
    inv = ROPE_BASE ** (-jnp.arange(n, dtype=F32) / n)
    ang = jnp.concatenate([row[:, None] * inv, col[:, None] * inv], axis=-1)
    return jnp.cos(ang).astype(dtype), jnp.sin(ang).astype(dtype)


def apply_rope(x, cos, sin):
    half = x.shape[-1] // 2
    x1, x2 = x[..., :half], x[..., half:]
    c, s = cos[:, None, :], sin[:, None, :]
    return jnp.concatenate([x1 * c - x2 * s, x1 * s + x2 * c], axis=-1)


def dwconv_centred(u, w, b):
    ch = u.shape[-1]
    y = lax.conv_general_dilated(u, w[:, None, :].astype(u.dtype), window_strides=(1,),
                                 padding=[((CONV_W - 1) // 2, CONV_W // 2)],
                                 dimension_numbers=('NWC', 'WIO', 'NWC'), feature_group_count=ch)
    return y + b


def linear_scan(a, b, h0, reverse):
    def combine(left, right):
        a1, b1 = left
        a2, b2 = right
        return a1 * a2, a2 * b1 + b2
    a_cum, h = lax.associative_scan(combine, (a, b), axis=1, reverse=reverse)
    h = h + a_cum * h0[:, None, :]
    h_final = h[:, 0] if reverse else h[:, -1]
    return h, h_final


def rglru_coeffs(u, w_r, b_r, w_i, b_i, lam):
    bsz, n_tok, _ = u.shape
    ub = u.reshape(bsz, n_tok, LRU_BLOCKS, LRU_BLOCK)
    r = jax.nn.sigmoid(jnp.einsum('blnc,ncd->blnd', ub, w_r).reshape(bsz, n_tok, LRU_WIDTH).astype(F32)
                       + b_r.astype(F32))
    i = jax.nn.sigmoid(jnp.einsum('blnc,ncd->blnd', ub, w_i).reshape(bsz, n_tok, LRU_WIDTH).astype(F32)
                       + b_i.astype(F32))
    log_a = -LRU_C * r * jax.nn.softplus(-lam.astype(F32))
    a = jnp.exp(log_a)
    bx = jnp.sqrt(-jnp.expm1(2.0 * log_a)) * i * u.astype(F32)
    return a, bx


def window_attention(q, k, v, k_ctx, v_ctx, sink):
    bsz, s_len, kv, grp, hd = q.shape
    c_len = k_ctx.shape[1]
    nb = s_len // WBLK
    qb = q.reshape(bsz, nb, WBLK, kv, grp, hd)

    def band(t):
        tp = jnp.pad(t, ((0, 0), (WBLK, WBLK), (0, 0), (0, 0))).reshape(bsz, nb + 2, WBLK, kv, hd)
        return jnp.concatenate([tp[:, :-2], tp[:, 1:-1], tp[:, 2:]], axis=2)

    kb, vb = band(k), band(v)
    scale = hd ** -0.5
    s_band = jnp.einsum('bnqhgd,bnkhd->bnhgqk', qb, kb).astype(F32) * scale
    qpos = jnp.arange(nb)[:, None, None] * WBLK + jnp.arange(WBLK)[None, :, None]
    kpos = jnp.arange(nb)[:, None, None] * WBLK - WBLK + jnp.arange(3 * WBLK)[None, None, :]
    valid = (jnp.abs(qpos - kpos) <= WINDOW) & (kpos >= 0) & (kpos < s_len)
    s_band = jnp.where(valid[None, :, None, None], s_band, -jnp.inf)
    s_ctx = jnp.einsum('bnqhgd,bkhd->bnhgqk', qb, k_ctx).astype(F32) * scale
    s_sink = jnp.broadcast_to(sink.astype(F32)[None, None, :, :, None, None], s_ctx.shape[:-1] + (1,))
    p = jax.nn.softmax(jnp.concatenate([s_sink, s_ctx, s_band], axis=-1), axis=-1).astype(v.dtype)
    o = (jnp.einsum('bnhgqk,bkhd->bnqhgd', p[..., 1:1 + c_len], v_ctx)
         + jnp.einsum('bnhgqk,bnkhd->bnqhgd', p[..., 1 + c_len:], vb))
    return o.reshape(bsz, s_len, kv * grp * hd)


def context_sink_attention(q, k, v, sink):
    bsz, c_len, kv, grp, hd = q.shape
    s = jnp.einsum('bqhgd,bkhd->bhgqk', q, k).astype(F32) * hd ** -0.5
    s_sink = jnp.broadcast_to(sink.astype(F32)[None, :, :, None, None], s.shape[:-1] + (1,))
    p = jax.nn.softmax(jnp.concatenate([s_sink, s], axis=-1), axis=-1)[..., 1:].astype(v.dtype)
    return jnp.einsum('bhgqk,bkhd->bqhgd', p, v).reshape(bsz, c_len, kv * grp * hd)


def diff_attention(q, k, v, lam, lam_init, subln_g):
    s = jnp.einsum('bqhmd,bkhmd->bhmqk', q, k).astype(F32) * DIFF_DH ** -0.5
    p = jax.nn.softmax(s, axis=-1)
    w = (p[:, :, 0] - lam * p[:, :, 1]).astype(v.dtype)
    o = jnp.einsum('bhqk,bkhe->bqhe', w, v)
    return rms_norm(o, subln_g) * (1.0 - lam_init)


def ssd_inputs(xbc, conv_w, conv_b):
    bsz, n_tok, _ = xbc.shape
    u = jax.nn.silu(dwconv_centred(xbc, conv_w, conv_b)).astype(F32)
    xs, bm, cm = jnp.split(u, (SSD_INNER, SSD_INNER + SSD_GROUPS * SSD_STATE), axis=-1)
    return (xs.reshape(bsz, n_tok, SSD_HEADS, SSD_HEAD_DIM),
            bm.reshape(bsz, n_tok, SSD_GROUPS, SSD_STATE),
            cm.reshape(bsz, n_tok, SSD_GROUPS, SSD_STATE))


def ssd_chunked(x, dt, a, bm, cm, h0, with_output):
    bsz, n_tok, n_h, n_p = x.shape
    n_g, n_n = bm.shape[2], bm.shape[3]
    n_r = n_h // n_g
    nc = n_tok // SSD_CHUNK
    q = SSD_CHUNK
    xc = x.reshape(bsz, nc, q, n_g, n_r, n_p)
    dtc = dt.reshape(bsz, nc, q, n_g, n_r)
    bc = bm.reshape(bsz, nc, q, n_g, n_n)
    acum = jnp.cumsum(dtc * a.reshape(n_g, n_r), axis=2)
    to_end = jnp.exp(acum[:, :, -1:] - acum) * dtc
    states = jnp.einsum('bclgn,bclgrp->bcgrpn', bc, xc * to_end[..., None])
    chunk_decay = jnp.exp(acum[:, :, -1])

    def step(h, inp):
        s_c, dcy = inp
        return dcy[..., None, None] * h + s_c, h

    h_fin, h_in = lax.scan(step, h0.reshape(bsz, n_g, n_r, n_p, n_n),
                           (jnp.moveaxis(states, 1, 0), jnp.moveaxis(chunk_decay, 1, 0)))
    h_fin = h_fin.reshape(bsz, n_h, n_p, n_n)
    if not with_output:
        return None, h_fin
    h_in = jnp.moveaxis(h_in, 0, 1)
    cc = cm.reshape(bsz, nc, q, n_g, n_n)
    seg = acum[:, :, :, None] - acum[:, :, None, :]
    lower = jnp.tril(jnp.ones((q, q), bool))[:, :, None, None]
    decay = jnp.exp(jnp.where(lower, seg, -jnp.inf))
    cb = jnp.einsum('bclgn,bcsgn->bclsg', cc, bc)
    w = cb[..., None] * decay * dtc[:, :, None]
    y = jnp.einsum('bclsgr,bcsgrp->bclgrp', w, xc)
    y = y + jnp.einsum('bclgn,bcgrpn->bclgrp', cc, h_in) * jnp.exp(acum)[..., None]
    return y.reshape(bsz, n_tok, n_h, n_p), h_fin


def ssd_dir(x, dt, a, bm, cm, h0, reverse, with_output):
    if reverse:
        x, dt, bm, cm = (jnp.flip(t, axis=1) for t in (x, dt, bm, cm))
    y, h_fin = ssd_chunked(x, dt, a, bm, cm, h0, with_output)
    if reverse and with_output:
        y = jnp.flip(y, axis=1)
    return y, h_fin


def gated_group_norm(y, z, g):
    bsz, n_tok = y.shape[:2]
    gs = SSD_INNER // SSD_GROUPS
    yz = y.reshape(bsz, n_tok, SSD_GROUPS, gs) * jax.nn.silu(z.astype(F32)).reshape(bsz, n_tok, SSD_GROUPS, gs)
    return rms_norm(yz, g.reshape(SSD_GROUPS, gs)).reshape(bsz, n_tok, SSD_INNER).astype(z.dtype)


def mixer_rglru_window(hl, hc, w_in, w_out, conv_w, conv_b, w_r, b_r, w_i, b_i, lam, sink, ctx_out):
    bsz, s_len, _ = hl.shape
    c_len = hc.shape[1]
    grp = WIN_HEADS // WIN_KV_HEADS
    gate_l, q_l, xa_l, k_l, v_l = jnp.split(hl @ w_in, AB_SPLITS, axis=-1)
    if ctx_out:
        gate_c, q_c, xa_c, k_c, v_c = jnp.split(hc @ w_in, AB_SPLITS, axis=-1)
    else:
        xa_c, k_c, v_c = jnp.split(hc @ w_in[:, AB_CTX_START:], AB_CTX_SPLITS, axis=-1)
    u_l = dwconv_centred(xa_l, conv_w, conv_b)
    u_c = dwconv_centred(xa_c, conv_w, conv_b)
    rec_l = jnp.zeros(u_l.shape, F32)
    rec_c = jnp.zeros(u_c.shape, F32)
    for d, rev in enumerate((False, True)):
        a_c, bx_c = rglru_coeffs(u_c, w_r[d], b_r[d], w_i[d], b_i[d], lam[d])
        h_c, h_c_final = linear_scan(a_c, bx_c, jnp.zeros((bsz, LRU_WIDTH), F32), rev)
        a_l, bx_l = rglru_coeffs(u_l, w_r[d], b_r[d], w_i[d], b_i[d], lam[d])
        h_l, _ = linear_scan(a_l, bx_l, h_c_final, rev)
        rec_l = rec_l + h_l
        if ctx_out:
            rec_c = rec_c + h_c
    cos, sin = axial_rope_tables(s_len, HEAD_DIM, hl.dtype)
    q_l = apply_rope(q_l.reshape(bsz, s_len, WIN_HEADS, HEAD_DIM), cos, sin).reshape(
        bsz, s_len, WIN_KV_HEADS, grp, HEAD_DIM)
    k_l = apply_rope(k_l.reshape(bsz, s_len, WIN_KV_HEADS, HEAD_DIM), cos, sin)
    v_l = v_l.reshape(bsz, s_len, WIN_KV_HEADS, HEAD_DIM)
    k_c = k_c.reshape(bsz, c_len, WIN_KV_HEADS, HEAD_DIM)
    v_c = v_c.reshape(bsz, c_len, WIN_KV_HEADS, HEAD_DIM)
    sink = sink.reshape(WIN_KV_HEADS, grp)
    att_l = window_attention(q_l, k_l, v_l, k_c, v_c, sink)
    lru_l = rec_l.astype(hl.dtype) * jax.nn.gelu(gate_l)
    out_l = jnp.concatenate([lru_l, att_l], axis=-1) @ w_out
    if not ctx_out:
        return out_l, None
    att_c = context_sink_attention(q_c.reshape(bsz, c_len, WIN_KV_HEADS, grp, HEAD_DIM), k_c, v_c, sink)
    lru_c = rec_c.astype(hc.dtype) * jax.nn.gelu(gate_c)
    out_c = jnp.concatenate([lru_c, att_c], axis=-1) @ w_out
    return out_l, out_c


def mixer_diff_ssd(hl, hc, w_in, w_out, lam_vecs, subln_g, conv_w, conv_b, dt_bias, a_log, d_skip,
                   norm_g, lam_init, ctx_out):
    bsz, s_len, _ = hl.shape
    c_len = hc.shape[1]
    q_l, z_l, k_l, v_l, xbc_l, dt_l = jnp.split(hl @ w_in, CD_SPLITS, axis=-1)
    if ctx_out:
        q_c, z_c, k_c, v_c, xbc_c, dt_c = jnp.split(hc @ w_in, CD_SPLITS, axis=-1)
    else:
        k_c, v_c, xbc_c, dt_c = jnp.split(hc @ w_in[:, CD_CTX_START:], CD_CTX_SPLITS, axis=-1)
    lv = lam_vecs.astype(F32)
    lam = jnp.exp(jnp.sum(lv[0] * lv[1])) - jnp.exp(jnp.sum(lv[2] * lv[3])) + lam_init
    cos, sin = axial_rope_tables(s_len, DIFF_DH, hl.dtype)

    def rope_qk(t):
        t = t.reshape(bsz, s_len, 2 * DIFF_HEADS, DIFF_DH)
        return apply_rope(t, cos, sin).reshape(bsz, s_len, DIFF_HEADS, 2, DIFF_DH)

    q_l, k_l = rope_qk(q_l), rope_qk(k_l)
    k_c = k_c.reshape(bsz, c_len, DIFF_HEADS, 2, DIFF_DH)
    v_c = v_c.reshape(bsz, c_len, DIFF_HEADS, 2 * DIFF_DH)
    k_all = jnp.concatenate([k_c, k_l], axis=1)
    v_all = jnp.concatenate([v_c, v_l.reshape(bsz, s_len, DIFF_HEADS, 2 * DIFF_DH)], axis=1)
    nb = s_len // QBLK
    q_blocks = jnp.moveaxis(q_l.reshape(bsz, nb, QBLK, DIFF_HEADS, 2, DIFF_DH), 1, 0)
    o_blocks = lax.map(lambda qb: diff_attention(qb, k_all, v_all, lam, lam_init, subln_g), q_blocks)
    diff_l = jnp.moveaxis(o_blocks, 0, 1).reshape(bsz, s_len, CD_V)
    x_l, bm_l, cm_l = ssd_inputs(xbc_l, conv_w, conv_b)
    x_c, bm_c, cm_c = ssd_inputs(xbc_c, conv_w, conv_b)
    dsk = d_skip.astype(F32)[:, None]
    y_l = dsk * x_l
    y_c = dsk * x_c if ctx_out else None
    h_zero = jnp.zeros((bsz, SSD_HEADS, SSD_HEAD_DIM, SSD_STATE), F32)
    for d, rev in enumerate((False, True)):
        a_d = -jnp.exp(a_log[d].astype(F32))
        cols = slice(d * SSD_HEADS, (d + 1) * SSD_HEADS)
        dt_c_d = jax.nn.softplus(dt_c[..., cols].astype(F32) + dt_bias[d].astype(F32))
        dt_l_d = jax.nn.softplus(dt_l[..., cols].astype(F32) + dt_bias[d].astype(F32))
        yc_d, h_c_final = ssd_dir(x_c, dt_c_d, a_d, bm_c, cm_c, h_zero, rev, ctx_out)
        yl_d, _ = ssd_dir(x_l, dt_l_d, a_d, bm_l, cm_l, h_c_final, rev, True)
        y_l = y_l + yl_d
        if ctx_out:
            y_c = y_c + yc_d
    ssd_l = gated_group_norm(y_l, z_l, norm_g)
    out_l = jnp.concatenate([diff_l, ssd_l], axis=-1) @ w_out
    if not ctx_out:
        return out_l, None
    diff_c = diff_attention(q_c.reshape(bsz, c_len, DIFF_HEADS, 2, DIFF_DH), k_c, v_c, lam, lam_init,
                            subln_g).reshape(bsz, c_len, CD_V)
    ssd_c = gated_group_norm(y_c, z_c, norm_g)
    out_c = jnp.concatenate([diff_c, ssd_c], axis=-1) @ w_out
    return out_l, out_c


def moe_ffn(h, w_router, b_router, w_gate, w_up, w_down, ws_gate, ws_up, ws_down):
    n_tok = h.shape[0]
    per = N_EXPERTS // N_EXPERT_GROUPS
    scores = jax.nn.sigmoid((h @ w_router).astype(F32))
    sel = scores + b_router.astype(F32)
    grp_score = jnp.sum(lax.top_k(sel.reshape(n_tok, N_EXPERT_GROUPS, per), 2)[0], axis=-1)
    _, top_grp = lax.top_k(grp_score, TOPK_GROUPS)
    grp_mask = jnp.any(top_grp[..., None] == jnp.arange(N_EXPERT_GROUPS), axis=1)
    sel = jnp.where(jnp.repeat(grp_mask, per, axis=1), sel, -jnp.inf)
    _, idx = lax.top_k(sel, TOP_K)
    gate = jnp.take_along_axis(scores, idx, axis=1)
    gate = gate / jnp.sum(gate, axis=-1, keepdims=True) * ROUTED_SCALE
    n_slots = n_tok * TOP_K
    e_flat = idx.reshape(-1)
    order = jnp.argsort(e_flat)
    e_sorted = e_flat[order]
    tok_sorted = (order // TOP_K).astype(jnp.int32)
    w_sorted = gate.reshape(-1)[order]
    counts = jnp.bincount(e_flat, length=N_EXPERTS)
    padded = (counts + EXPERT_BLK - 1) // EXPERT_BLK * EXPERT_BLK
    start = jnp.cumsum(counts) - counts
    pend = jnp.cumsum(padded)
    pstart = pend - padded
    dest = pstart[e_sorted] + jnp.arange(n_slots) - start[e_sorted]
    n_blocks = -(-n_slots // EXPERT_BLK) + N_EXPERTS
    cap = n_blocks * EXPERT_BLK
    buf_tok = jnp.zeros((cap,), jnp.int32).at[dest].set(tok_sorted)
    buf_w = jnp.zeros((cap,), F32).at[dest].set(w_sorted)
    blk_e = jnp.minimum(jnp.searchsorted(pend, jnp.arange(n_blocks) * EXPERT_BLK, side='right'), N_EXPERTS - 1)

    def body(acc, blk):
        e, tok, w = blk
        xb = h[tok]
        y = (jax.nn.silu(xb @ w_gate[e]) * (xb @ w_up[e])) @ w_down[e]
        return acc.at[tok].add(y * w[:, None].astype(y.dtype)), None

    routed, _ = lax.scan(body, jnp.zeros_like(h),
                         (blk_e, buf_tok.reshape(n_blocks, EXPERT_BLK), buf_w.reshape(n_blocks, EXPERT_BLK)))
    shared = (jax.nn.silu(h @ ws_gate) * (h @ ws_up)) @ ws_down
    return shared + routed


def setup_inputs(seed: int = 0) -> dict:
    key = jax.random.key(seed)
    keys = iter(jax.random.split(key, 64))

    def nrm(shape, scale):
        return jax.random.normal(next(keys), shape, F32) * scale

    def unif(shape, lo, hi):
        return jax.random.uniform(next(keys), shape, F32, lo, hi)

    dm = D_MODEL
    a0 = unif((N_EVEN, 2, LRU_WIDTH), 0.9, 0.999) ** (1.0 / LRU_C)
    dt0 = jnp.exp(unif((N_ODD, 2, SSD_HEADS), math.log(1e-3), math.log(1e-1)))
    return {
        'x': nrm((BATCH, SEQ, dm), 1.0),
        'c': nrm((BATCH, dm), 1.0),
        'ctx': nrm((BATCH, CTX_LEN, dm), 1.0),
        'c_ctx': nrm((dm,), 1.0),
        'w_mod': nrm((DEPTH, dm, N_MOD * dm), 0.5 * dm ** -0.5),
        'b_mod': nrm((DEPTH, N_MOD * dm), 0.02),
        'g_mix': 1.0 + nrm((DEPTH, dm), 0.02),
        'g_ffn': 1.0 + nrm((DEPTH, dm), 0.02),
        'g_final': 1.0 + nrm((dm,), 0.02),
        'ab_w_in': nrm((N_EVEN, dm, AB_IN), dm ** -0.5),
        'ab_w_out': nrm((N_EVEN, AB_OUT, dm), AB_OUT ** -0.5),
        'ab_conv_w': nrm((N_EVEN, CONV_W, LRU_WIDTH), CONV_W ** -0.5),
        'ab_conv_b': nrm((N_EVEN, LRU_WIDTH), 0.02),
        'ab_w_r': nrm((N_EVEN, 2, LRU_BLOCKS, LRU_BLOCK, LRU_BLOCK), LRU_BLOCK ** -0.5),
        'ab_b_r': nrm((N_EVEN, 2, LRU_WIDTH), 0.02),
        'ab_w_i': nrm((N_EVEN, 2, LRU_BLOCKS, LRU_BLOCK, LRU_BLOCK), LRU_BLOCK ** -0.5),
        'ab_b_i': nrm((N_EVEN, 2, LRU_WIDTH), 0.02),
        'ab_lam': jnp.log(a0) - jnp.log1p(-a0),
        'ab_sink': nrm((N_EVEN, WIN_HEADS), 0.5),
        'cd_w_in': nrm((N_ODD, dm, CD_IN), dm ** -0.5),
        'cd_w_out': nrm((N_ODD, CD_OUT, dm), CD_OUT ** -0.5),
        'cd_lam': nrm((N_ODD, 4, DIFF_DH), 0.1),
        'cd_subln_g': 1.0 + nrm((N_ODD, 2 * DIFF_DH), 0.02),
        'cd_conv_w': nrm((N_ODD, CONV_W, SSD_CONV_DIM), CONV_W ** -0.5),
        'cd_conv_b': nrm((N_ODD, SSD_CONV_DIM), 0.02),
        'cd_dt_bias': dt0 + jnp.log(-jnp.expm1(-dt0)),
        'cd_a_log': jnp.log(unif((N_ODD, 2, SSD_HEADS), 1.0, 16.0)),
        'cd_d_skip': 1.0 + nrm((N_ODD, SSD_HEADS), 0.1),
        'cd_norm_g': 1.0 + nrm((N_ODD, SSD_INNER), 0.02),
        'w_router': nrm((DEPTH, dm, N_EXPERTS), dm ** -0.5),
        'b_router': nrm((DEPTH, N_EXPERTS), 0.01),
        'w_e_gate': nrm((DEPTH, N_EXPERTS, dm, D_EXPERT), dm ** -0.5),
        'w_e_up': nrm((DEPTH, N_EXPERTS, dm, D_EXPERT), dm ** -0.5),
        'w_e_down': nrm((DEPTH, N_EXPERTS, D_EXPERT, dm), D_EXPERT ** -0.5),
        'ws_gate': nrm((DEPTH, dm, D_SHARED), dm ** -0.5),
        'ws_up': nrm((DEPTH, dm, D_SHARED), dm ** -0.5),
        'ws_down': nrm((DEPTH, D_SHARED, dm), D_SHARED ** -0.5),
    }


def reference(x, c, ctx, c_ctx, w_mod, b_mod, g_mix, g_ffn, g_final,
              ab_w_in, ab_w_out, ab_conv_w, ab_conv_b, ab_w_r, ab_b_r, ab_w_i, ab_b_i, ab_lam, ab_sink,
              cd_w_in, cd_w_out, cd_lam, cd_subln_g, cd_conv_w, cd_conv_b, cd_dt_bias, cd_a_log, cd_d_skip,
              cd_norm_g, w_router, b_router, w_e_gate, w_e_up, w_e_down, ws_gate, ws_up, ws_down):
    bsz, s_len, dm = x.shape
    c_len = ctx.shape[1]
    cs = jax.nn.silu(c)
    ccs = jax.nn.silu(c_ctx)
    for l in range(DEPTH):
        last = l == DEPTH - 1
        i = l // 2
        ml = (cs @ w_mod[l] + b_mod[l])[:, None, :]
        mc = ccs @ w_mod[l] + b_mod[l]
        sh1, sc1, g1, sh2, sc2, g2 = jnp.split(ml, N_MOD, axis=-1)
        csh1, csc1, cg1, csh2, csc2, cg2 = jnp.split(mc, N_MOD, axis=-1)
        hl = modulate(rms_norm(x, g_mix[l]), sh1, sc1)
        hc = modulate(rms_norm(ctx, g_mix[l]), csh1, csc1)
        if l % 2 == 0:
            ol, oc = mixer_rglru_window(hl, hc, ab_w_in[i], ab_w_out[i], ab_conv_w[i], ab_conv_b[i], ab_w_r[i],
                                        ab_b_r[i], ab_w_i[i], ab_b_i[i], ab_lam[i], ab_sink[i], not last)
        else:
            lam_init = 0.8 - 0.6 * math.exp(-0.3 * l)
            ol, oc = mixer_diff_ssd(hl, hc, cd_w_in[i], cd_w_out[i], cd_lam[i], cd_subln_g[i], cd_conv_w[i],
                                    cd_conv_b[i], cd_dt_bias[i], cd_a_log[i], cd_d_skip[i], cd_norm_g[i],
                                    lam_init, not last)
        x = x + g1 * ol
        hl = modulate(rms_norm(x, g_ffn[l]), sh2, sc2).reshape(bsz * s_len, dm)
        moe_w = (w_router[l], b_router[l], w_e_gate[l], w_e_up[l], w_e_down[l], ws_gate[l], ws_up[l], ws_down[l])
        if last:
            x = x + g2 * moe_ffn(hl, *moe_w).reshape(bsz, s_len, dm)
        else:
            ctx = ctx + cg1 * oc
            hc = modulate(rms_norm(ctx, g_ffn[l]), csh2, csc2).reshape(bsz * c_len, dm)
            f = moe_ffn(jnp.concatenate([hl, hc], axis=0), *moe_w)
            x = x + g2 * f[:bsz * s_len].reshape(bsz, s_len, dm)
            ctx = ctx + cg2 * f[bsz * s_len:].reshape(bsz, c_len, dm)
    return rms_norm(x, g_final)
```

```cpp
#ifndef HIP_EMU
#include <hip/hip_runtime.h>
#include <hip/hip_cooperative_groups.h>
#endif
#include <cstdio>
#include <cstdint>
#include <cmath>

#ifndef CFG_D
#define CFG_D 1024
#define CFG_B 8
#define CFG_S 2048
#define CFG_C 256
#define CFG_E 64
#define CFG_DE 256
#endif

#define DEV __device__ __forceinline__

constexpr int DM = CFG_D, NB = CFG_B, SEQ = CFG_S, CTX = CFG_C, NE = CFG_E, DE = CFG_DE;
constexpr int TL = NB * SEQ, TC = NB * CTX, TT = TL + TC, KVL = CTX + SEQ;
constexpr int GRIDW = 64;
constexpr int LRUW = 512, LRUB = 8;
constexpr int AB_IN = 1792, CD_IN = 3088;
constexpr int LDP = 3200;
constexpr int LDC = 1024;
constexpr int NMOD = 6, NR = NB + 1;
constexpr int PER = NE / 8;
constexpr int NCC = CTX / 128, NCL = SEQ / 128, NCH = NCC + NCL;
constexpr int LCH = 32;
constexpr int LNC = CTX / LCH, LNL = SEQ / LCH, LNT = LNC + LNL;
constexpr float EPS = 1e-6f;
static_assert(DM % 256 == 0 && SEQ % 128 == 0 && CTX % 128 == 0 && DE % 64 == 0 && NE % 8 == 0 && NE <= 64, "dims");

typedef unsigned short bf16;
typedef short bf16x8 __attribute__((ext_vector_type(8)));
typedef short bf16x4 __attribute__((ext_vector_type(4)));
typedef float f32x4 __attribute__((ext_vector_type(4)));
typedef float f32x2 __attribute__((ext_vector_type(2)));
typedef unsigned u32x4 __attribute__((ext_vector_type(4)));
typedef unsigned u32x2 __attribute__((ext_vector_type(2)));

constexpr size_t al256(size_t x) { return (x + 255) & ~(size_t)255; }
constexpr size_t WS_CTL = 0;
constexpr size_t CTL_BYTES = 65536;
constexpr int CW_CNT = 8192;
constexpr size_t WS_MOD = WS_CTL + CTL_BYTES;
constexpr size_t WS_ROPE = al256(WS_MOD + (size_t)2 * NR * NMOD * DM * 4);
constexpr size_t WS_SCAL = al256(WS_ROPE + (size_t)SEQ * 64 * 4);
constexpr size_t WS_REF = al256(WS_SCAL + 256);
constexpr size_t WS_LIST = al256(WS_REF + (size_t)TT * 8 * 4);
constexpr size_t WS_LISTW = al256(WS_LIST + (size_t)NE * TT * 4);
constexpr size_t WS_X = al256(WS_LISTW + (size_t)NE * TT * 4);
constexpr size_t WS_ACT = al256(WS_X + (size_t)TT * DM * 4);
constexpr size_t WS_BIG = al256(WS_ACT + (size_t)TT * 9 * DE * 2);
constexpr size_t WS_HB = WS_ACT;
constexpr size_t WS_Y = WS_BIG;
constexpr size_t WS_HA = WS_BIG;
constexpr size_t WS_PROJ = al256(WS_HA + (size_t)TT * DM * 2);
constexpr size_t WS_CAT = al256(WS_PROJ + (size_t)TT * LDP * 2);
constexpr size_t WS_VT = al256(WS_CAT + (size_t)TT * LDC * 2);
constexpr size_t WS_U = al256(WS_VT + (size_t)NB * 4 * 128 * KVL * 2);
constexpr size_t WS_DTV = al256(WS_U + (size_t)TT * 1024 * 2);
constexpr size_t WS_ST = al256(WS_DTV + (size_t)TT * 16 * 4);
constexpr size_t WS_DEC = al256(WS_ST + (size_t)NB * NCH * 2 * 8 * 8192 * 4);
constexpr size_t WS_AGG = al256(WS_DEC + (size_t)NB * NCH * 16 * 4);
constexpr size_t WS_MIXEND = al256(WS_AGG + (size_t)NB * LNT * 4 * 512 * 4);
constexpr size_t WS_YEND = al256(WS_Y + (size_t)TT * 9 * DM * 2);
constexpr size_t WS_TOTAL = WS_MIXEND > WS_YEND ? WS_MIXEND : WS_YEND;

constexpr int SMEM_BYTES = 71680;

#ifdef HIP_EMU
#define MFMA16(a, b, c) emu_mfma_16x16x32_bf16(a, b, c)
#define WAIT_VM0() do {} while (0)
DEV void glds16(const void* g, void* l) { emu_glds16(g, l); }
#else
#define MFMA16(a, b, c) __builtin_amdgcn_mfma_f32_16x16x32_bf16(a, b, c, 0, 0, 0)
#define WAIT_VM0() asm volatile("s_waitcnt vmcnt(0)" ::: "memory")
DEV void glds16(const void* g, void* l) {
    __builtin_amdgcn_global_load_lds((const __attribute__((address_space(1))) unsigned*)g, (__attribute__((address_space(3))) unsigned*)l, 16, 0, 0);
}
#endif

DEV unsigned f2bf(float f) { unsigned u = __builtin_bit_cast(unsigned, f); return (u + 0x7fffu + ((u >> 16) & 1u)) >> 16; }
DEV float bf2f(unsigned h) { return __builtin_bit_cast(float, h << 16); }
DEV unsigned pk2(float lo, float hi) { return f2bf(lo) | (f2bf(hi) << 16); }
DEV float bflo(unsigned u) { return __builtin_bit_cast(float, u << 16); }
DEV float bfhi(unsigned u) { return __builtin_bit_cast(float, u & 0xffff0000u); }
DEV float sigmoidf_(float x) { return 1.0f / (1.0f + __expf(-x)); }
DEV float siluf_(float x) { return x * sigmoidf_(x); }
DEV float softplusf_(float x) { return x > 20.f ? x : log1pf(__expf(x)); }
DEV float geluf_(float x) { float u = 0.7978845608028654f * (x + 0.044715f * x * x * x); float e = __expf(-2.0f * fabsf(u)); float t = (1.0f - e) / (1.0f + e); t = u < 0.f ? -t : t; return 0.5f * x * (1.0f + t); }
DEV float wave_sum(float v) {
#pragma unroll
    for (int m = 32; m >= 1; m >>= 1) v += __shfl_xor(v, m);
    return v;
}
DEV bf16x8 pack8(float a0, float a1, float a2, float a3, float a4, float a5, float a6, float a7) {
    u32x4 u; u.x = pk2(a0, a1); u.y = pk2(a2, a3); u.z = pk2(a4, a5); u.w = pk2(a6, a7); return __builtin_bit_cast(bf16x8, u);
}
DEV void st_bf16x4(bf16* p, float a, float b, float c, float d) { u32x2 u; u.x = pk2(a, b); u.y = pk2(c, d); *(u32x2*)p = u; }

enum { I_x, I_c, I_ctx, I_c_ctx, I_w_mod, I_b_mod, I_g_mix, I_g_ffn, I_g_final,
       I_ab_w_in, I_ab_w_out, I_ab_conv_w, I_ab_conv_b, I_ab_w_r, I_ab_b_r, I_ab_w_i, I_ab_b_i, I_ab_lam, I_ab_sink,
       I_cd_w_in, I_cd_w_out, I_cd_lam, I_cd_subln_g, I_cd_conv_w, I_cd_conv_b, I_cd_dt_bias, I_cd_a_log, I_cd_d_skip, I_cd_norm_g,
       I_w_router, I_b_router, I_w_e_gate, I_w_e_up, I_w_e_down, I_ws_gate, I_ws_up, I_ws_down, N_IN };

struct Params { const float* in[N_IN]; float* out; char* ws; };

DEV int mod_row(int t) { return t < TL ? t / SEQ : NB; }
DEV const float* modp(const Params& p, int l, int t, int which) { return (const float*)(p.ws + WS_MOD) + ((size_t)(l * NR + mod_row(t)) * NMOD + which) * DM; }

constexpr int MOD_CG = NMOD * DM / 64;
DEV void mod_item(const Params& p, char* smem, int it) {
    const int tid = threadIdx.x, l = it / MOD_CG, cg = it % MOD_CG;
    float* S = (float*)smem;
    float* RED = S + NR * DM;
    __syncthreads();
    for (int i = tid; i < NR * DM; i += 256) { int r = i / DM, k = i % DM; float v = r < NB ? p.in[I_c][r * DM + k] : p.in[I_c_ctx][k]; S[i] = siluf_(v); }
    __syncthreads();
    const int col = cg * 64 + (tid & 63), ks = tid >> 6;
    const float* W = p.in[I_w_mod] + (size_t)l * DM * NMOD * DM + col;
    float acc[NR];
#pragma unroll
    for (int r = 0; r < NR; ++r) acc[r] = 0.f;
    for (int k = ks * (DM / 4); k < (ks + 1) * (DM / 4); ++k) {
        float w = W[(size_t)k * NMOD * DM];
#pragma unroll
        for (int r = 0; r < NR; ++r) acc[r] += S[r * DM + k] * w;
    }
#pragma unroll
    for (int r = 0; r < NR; ++r) RED[(ks * NR + r) * 64 + (tid & 63)] = acc[r];
    __syncthreads();
    for (int i = tid; i < NR * 64; i += 256) { int r = i / 64, c = i % 64;
        float v = RED[(0 * NR + r) * 64 + c] + RED[(1 * NR + r) * 64 + c] + RED[(2 * NR + r) * 64 + c] + RED[(3 * NR + r) * 64 + c];
        int cc = cg * 64 + c; ((float*)(p.ws + WS_MOD))[(size_t)(l * NR + r) * NMOD * DM + cc] = v + p.in[I_b_mod][l * NMOD * DM + cc]; }
}
DEV void rope_item(const Params& p, int it) {
    int i = it * 256 + threadIdx.x;
    if (i < SEQ * 32) { int s = i >> 5, j = i & 31; float pos = (float)(j < 16 ? s / GRIDW : s % GRIDW);
        float inv = powf(10000.0f, -(float)(j & 15) / 16.0f); float ang = pos * inv;
        ((float*)(p.ws + WS_ROPE))[i] = cosf(ang); ((float*)(p.ws + WS_ROPE))[SEQ * 32 + i] = sinf(ang); }
}
DEV void lam_item(const Params& p) {
    if (threadIdx.x < 64) { const float* lv = p.in[I_cd_lam]; int i = threadIdx.x;
        float a = wave_sum(lv[i] * lv[64 + i]), b = wave_sum(lv[128 + i] * lv[192 + i]);
        if (i == 0) { float lam_init = 0.8f - 0.6f * expf(-0.3f); ((float*)(p.ws + WS_SCAL))[0] = expf(a) - expf(b) + lam_init; ((float*)(p.ws + WS_SCAL))[1] = lam_init; } }
}

constexpr int NV = DM / 256;
DEV void load_row(const float* row, int lane, f32x4 (&v)[NV]) {
#pragma unroll
    for (int i = 0; i < NV; ++i) v[i] = *(const f32x4*)(row + i * 256 + lane * 4);
}
DEV float row_rstd(const f32x4 (&v)[NV]) {
    float ss = 0.f;
#pragma unroll
    for (int i = 0; i < NV; ++i) ss += v[i][0] * v[i][0] + v[i][1] * v[i][1] + v[i][2] * v[i][2] + v[i][3] * v[i][3];
    ss = wave_sum(ss); return rsqrtf(ss * (1.0f / DM) + EPS);
}
DEV void norm_mod(const f32x4 (&v)[NV], float rstd, const float* g, const float* shift, const float* scale, int lane, f32x4 (&h)[NV]) {
#pragma unroll
    for (int i = 0; i < NV; ++i) { int k = i * 256 + lane * 4; f32x4 gg = *(const f32x4*)(g + k), sh = *(const f32x4*)(shift + k), sc = *(const f32x4*)(scale + k);
#pragma unroll
        for (int j = 0; j < 4; ++j) h[i][j] = v[i][j] * rstd * gg[j] * (1.0f + sc[j]) + sh[j]; }
}
DEV void store_row_bf16(bf16* row, int lane, const f32x4 (&h)[NV]) {
#pragma unroll
    for (int i = 0; i < NV; ++i) st_bf16x4(row + i * 256 + lane * 4, h[i][0], h[i][1], h[i][2], h[i][3]);
}
DEV void norm0_item(const Params& p, int it) {
    const int lane = threadIdx.x & 63, t = it * 4 + (threadIdx.x >> 6);
    const float* row = t < TL ? p.in[I_x] + (size_t)t * DM : p.in[I_ctx] + (size_t)(t - TL) * DM;
    f32x4 v[NV], h[NV]; load_row(row, lane, v); float rstd = row_rstd(v);
    norm_mod(v, rstd, p.in[I_g_mix], modp(p, 0, t, 0), modp(p, 0, t, 1), lane, h);
    store_row_bf16((bf16*)(p.ws + WS_HA) + (size_t)t * DM, lane, h);
}

struct GemmA { const bf16* A; int lda; const int* list; int row0; int nvalid; };
struct GemmB { const float* p0; const float* p1; int ldb; int n0; int N; int mode; int K; };
DEV const float* gemm_bcol(const float* q0, const float* q1, int mode, int n0, int N, int nl) {
    if (mode == 0) { int c = n0 + nl; return c < N ? q0 + c : nullptr; }
    int wc = nl >> 6, nf = (nl >> 4) & 3, i = nl & 15; int c = n0 + wc * 32 + (nf & 1) * 16 + i; const float* q = q0; if (nf >> 1) q = q1; return q + c;
}
template <class Epi> DEV void gemm_tile(char* smem, const GemmA& a, const GemmB& b, Epi& epi) {
    char* SA = smem; char* SB = smem + 8192;
    const int tid = threadIdx.x, lane = tid & 63, wid = tid >> 6, wr = wid >> 1, wc = wid & 1, fr = lane & 15, fq = lane >> 4;
    const bf16* pA[2];
#pragma unroll
    for (int i = 0; i < 2; ++i) { int r = (tid >> 2) + i * 64; int rr = r < a.nvalid ? r : a.nvalid - 1; int grow = a.list ? a.list[rr] : a.row0 + rr;
        pA[i] = a.A + (size_t)grow * a.lda + (tid & 3) * 8; }
    const int kg = tid >> 6, nq = tid & 63;
    const float* pB = gemm_bcol(b.p0, b.p1, b.mode, b.n0, b.N, nq * 2); if (pB) pB += (size_t)(kg * 8) * b.ldb;
    f32x4 acc[4][4];
#pragma unroll
    for (int m = 0; m < 4; ++m)
#pragma unroll
        for (int n = 0; n < 4; ++n) acc[m][n] = (f32x4){0.f, 0.f, 0.f, 0.f};
    const int nk = b.K / 32;
    __syncthreads();
    for (int kt = 0; kt < nk; ++kt) {
        glds16(pA[0] + kt * 32, SA + tid * 16); glds16(pA[1] + kt * 32, SA + tid * 16 + 4096);
        f32x2 v[8];
#pragma unroll
        for (int i = 0; i < 8; ++i) v[i] = pB ? *(const f32x2*)(pB + (size_t)(kt * 32 + i) * b.ldb) : (f32x2){0.f, 0.f};
        *(bf16x8*)(SB + (nq * 2) * 64 + kg * 16) = pack8(v[0].x, v[1].x, v[2].x, v[3].x, v[4].x, v[5].x, v[6].x, v[7].x);
        *(bf16x8*)(SB + (nq * 2 + 1) * 64 + kg * 16) = pack8(v[0].y, v[1].y, v[2].y, v[3].y, v[4].y, v[5].y, v[6].y, v[7].y);
        WAIT_VM0(); __syncthreads();
        bf16x8 At[4], Bt[4];
#pragma unroll
        for (int m = 0; m < 4; ++m) At[m] = *(const bf16x8*)(SA + (wr * 64 + m * 16 + fr) * 64 + fq * 16);
#pragma unroll
        for (int n = 0; n < 4; ++n) Bt[n] = *(const bf16x8*)(SB + (wc * 64 + n * 16 + fr) * 64 + fq * 16);
#pragma unroll
        for (int m = 0; m < 4; ++m)
#pragma unroll
            for (int n = 0; n < 4; ++n) acc[m][n] = MFMA16(Bt[n], At[m], acc[m][n]);
        __syncthreads();
    }
    epi(acc, wr * 64 + fr, wc * 64 + fq * 4);
}

enum { CT_RAW = 0, CT_GELU = 1, CT_ROPE_SCALE = 2, CT_ROPE = 3, CT_VT = 4 };
struct EpiProj {
    const Params* p; int row0; int n0; int N; int ctype; int vcol0; int vdim; int vheads;
    DEV void operator()(f32x4 (&acc)[4][4], int rl0, int cl0) const {
        bf16* PROJ = (bf16*)(p->ws + WS_PROJ);
        const float* RC = (const float*)(p->ws + WS_ROPE); const float* RS = RC + SEQ * 32;
#pragma unroll
        for (int m = 0; m < 4; ++m) {
            const int t = row0 + rl0 + m * 16; const bool lat = t < TL; const int s = lat ? t % SEQ : 0;
            if (ctype == CT_ROPE_SCALE || ctype == CT_ROPE) {
                const float sc = ctype == CT_ROPE_SCALE ? 0.125f : 1.0f;
#pragma unroll
                for (int n = 0; n < 2; ++n) {
                    f32x4 x1 = acc[m][n], x2 = acc[m][n + 2], o1, o2;
                    if (lat) { const int i0 = n * 16 + (cl0 & 15); f32x4 c = *(const f32x4*)(RC + s * 32 + i0), sn = *(const f32x4*)(RS + s * 32 + i0);
#pragma unroll
                        for (int j = 0; j < 4; ++j) { o1[j] = (x1[j] * c[j] - x2[j] * sn[j]) * sc; o2[j] = (x1[j] * sn[j] + x2[j] * c[j]) * sc; } }
                    else { o1 = x1 * sc; o2 = x2 * sc; }
                    acc[m][n] = o1; acc[m][n + 2] = o2;
                }
            }
#pragma unroll
            for (int n = 0; n < 4; ++n) {
                const int cl = cl0 + n * 16, c = n0 + cl; f32x4 v = acc[m][n];
                if (ctype == CT_GELU) {
#pragma unroll
                    for (int j = 0; j < 4; ++j) v[j] = geluf_(v[j]); }
                if (ctype == CT_VT) {
                    const int b = lat ? t / SEQ : (t - TL) / CTX; const int kk = lat ? CTX + s : (t - TL) % CTX;
                    bf16* VT = (bf16*)(p->ws + WS_VT);
#pragma unroll
                    for (int j = 0; j < 4; ++j) { int cv = c - vcol0 + j; int hh = cv / vdim, d = cv % vdim; VT[((size_t)(b * vheads + hh) * vdim + d) * KVL + kk] = (bf16)f2bf(v[j]); }
                } else if (c < N) st_bf16x4(PROJ + (size_t)t * LDP + c, v[0], v[1], v[2], v[3]);
            }
        }
    }
};
struct EpiOut {
    const Params* p; int row0; int n0; int layer;
    DEV void operator()(f32x4 (&acc)[4][4], int rl0, int cl0) const {
        float* X = (float*)(p->ws + WS_X);
#pragma unroll
        for (int m = 0; m < 4; ++m) { const int t = row0 + rl0 + m * 16;
            const float* xin = layer == 0 ? (t < TL ? p->in[I_x] + (size_t)t * DM : p->in[I_ctx] + (size_t)(t - TL) * DM) : X + (size_t)t * DM;
            const float* g1 = modp(*p, layer, t, 2);
#pragma unroll
            for (int n = 0; n < 4; ++n) { const int c = n0 + cl0 + n * 16; f32x4 xi = *(const f32x4*)(xin + c), g = *(const f32x4*)(g1 + c);
                *(f32x4*)(X + (size_t)t * DM + c) = xi + g * acc[m][n]; } }
    }
};
struct EpiG1 {
    bf16* ACT; int slot0; int nvalid; int hb;
    DEV void operator()(f32x4 (&acc)[4][4], int rl0, int cl0) const {
        const int wc = cl0 >> 6, fq4 = cl0 & 63;
#pragma unroll
        for (int m = 0; m < 4; ++m) { const int rl = rl0 + m * 16; if (rl < nvalid) {
#pragma unroll
            for (int n = 0; n < 2; ++n) { f32x4 g = acc[m][n], u = acc[m][n + 2];
                st_bf16x4(ACT + (size_t)(slot0 + rl) * DE + hb + wc * 32 + n * 16 + fq4, siluf_(g[0]) * u[0], siluf_(g[1]) * u[1], siluf_(g[2]) * u[2], siluf_(g[3]) * u[3]); } } }
    }
};
struct EpiG2 {
    bf16* Y; int slot0; int nvalid; int n0; const float* w;
    DEV void operator()(f32x4 (&acc)[4][4], int rl0, int cl0) const {
#pragma unroll
        for (int m = 0; m < 4; ++m) { const int rl = rl0 + m * 16; if (rl < nvalid) { const float ww = w ? w[rl] : 1.0f;
#pragma unroll
            for (int n = 0; n < 4; ++n) { f32x4 v = acc[m][n] * ww; st_bf16x4(Y + (size_t)(slot0 + rl) * DM + n0 + cl0 + n * 16, v[0], v[1], v[2], v[3]); } } }
    }
};

constexpr int KSTR = 144, VSTR = 144;
template <int DV, bool WINDOW>
DEV void flash_block(char* smem, const bf16* Qp, int ldq, const bf16* Kbase, int ldk, int ctx_row0, int lat_row0, const bf16* VTp,
                     int r0a, int r1a, int r0b, int r1b, int q0, float m_init, float l_init, f32x4 (&o)[DV / 16][2]) {
    char* SK = smem; char* SV = smem + 64 * KSTR;
    const int tid = threadIdx.x, lane = tid & 63, w = tid >> 6, fr = lane & 15, fq = lane >> 4;
    bf16x8 qfr[2][2];
#pragma unroll
    for (int qf = 0; qf < 2; ++qf)
#pragma unroll
        for (int ks = 0; ks < 2; ++ks) qfr[qf][ks] = *(const bf16x8*)(Qp + (size_t)(w * 32 + qf * 16 + fr) * ldq + ks * 32 + fq * 8);
    float mrow[2] = {m_init, m_init}, lrow[2] = {l_init, l_init};
#pragma unroll
    for (int df = 0; df < DV / 16; ++df) { o[df][0] = (f32x4){0.f, 0.f, 0.f, 0.f}; o[df][1] = (f32x4){0.f, 0.f, 0.f, 0.f}; }
    for (int rg = 0; rg < 2; ++rg) {
        const int k0 = rg ? r0b : r0a, k1 = rg ? r1b : r1a;
        for (int kk0 = k0; kk0 < k1; kk0 += 64) {
            __syncthreads();
#pragma unroll
            for (int i = 0; i < 2; ++i) { int c = tid + i * 256, key = c >> 3, part = c & 7; int kk = kk0 + key; int row = kk < CTX ? ctx_row0 + kk : lat_row0 + kk - CTX;
                *(u32x4*)(SK + key * KSTR + part * 16) = *(const u32x4*)(Kbase + (size_t)row * ldk + part * 8); }
#pragma unroll
            for (int i = 0; i < DV / 32; ++i) { int c = tid + i * 256, d = c >> 3, part = c & 7;
                *(u32x4*)(SV + d * VSTR + part * 16) = *(const u32x4*)(VTp + (size_t)d * KVL + kk0 + part * 8); }
            __syncthreads();
            f32x4 s[4][2];
#pragma unroll
            for (int kf = 0; kf < 4; ++kf) { s[kf][0] = (f32x4){0.f, 0.f, 0.f, 0.f}; s[kf][1] = (f32x4){0.f, 0.f, 0.f, 0.f};
#pragma unroll
                for (int ks = 0; ks < 2; ++ks) { bf16x8 kfrag = *(const bf16x8*)(SK + (kf * 16 + fr) * KSTR + ks * 64 + fq * 16);
                    s[kf][0] = MFMA16(kfrag, qfr[0][ks], s[kf][0]); s[kf][1] = MFMA16(kfrag, qfr[1][ks], s[kf][1]); } }
            if (WINDOW && kk0 >= CTX) {
#pragma unroll
                for (int kf = 0; kf < 4; ++kf)
#pragma unroll
                    for (int qf = 0; qf < 2; ++qf)
#pragma unroll
                        for (int j = 0; j < 4; ++j) { int kpos = kk0 - CTX + kf * 16 + fq * 4 + j, qpos = q0 + w * 32 + qf * 16 + fr; int dd = qpos - kpos; if (dd > 128 || dd < -128) s[kf][qf][j] = -1e30f; }
            }
            bf16x8 pfr[2][2];
#pragma unroll
            for (int qf = 0; qf < 2; ++qf) {
                float tm = -1e30f;
#pragma unroll
                for (int kf = 0; kf < 4; ++kf)
#pragma unroll
                    for (int j = 0; j < 4; ++j) tm = fmaxf(tm, s[kf][qf][j]);
                tm = fmaxf(tm, __shfl_xor(tm, 16)); tm = fmaxf(tm, __shfl_xor(tm, 32));
                const float mn = fmaxf(mrow[qf], tm), alpha = __expf(mrow[qf] - mn); mrow[qf] = mn;
                float rs = 0.f;
#pragma unroll
                for (int kf = 0; kf < 4; ++kf)
#pragma unroll
                    for (int j = 0; j < 4; ++j) { float e = __expf(s[kf][qf][j] - mn); s[kf][qf][j] = e; rs += e; }
                rs += __shfl_xor(rs, 16); rs += __shfl_xor(rs, 32);
                lrow[qf] = lrow[qf] * alpha + rs;
#pragma unroll
                for (int df = 0; df < DV / 16; ++df) o[df][qf] = o[df][qf] * alpha;
#pragma unroll
                for (int k2 = 0; k2 < 2; ++k2) pfr[qf][k2] = pack8(s[2 * k2][qf][0], s[2 * k2][qf][1], s[2 * k2][qf][2], s[2 * k2][qf][3], s[2 * k2 + 1][qf][0], s[2 * k2 + 1][qf][1], s[2 * k2 + 1][qf][2], s[2 * k2 + 1][qf][3]);
            }
#pragma unroll
            for (int df = 0; df < DV / 16; ++df)
#pragma unroll
                for (int k2 = 0; k2 < 2; ++k2) {
                    u32x2 lo = *(const u32x2*)(SV + (df * 16 + fr) * VSTR + (k2 * 32 + fq * 4) * 2), hi = *(const u32x2*)(SV + (df * 16 + fr) * VSTR + (k2 * 32 + 16 + fq * 4) * 2);
                    u32x4 vv; vv.x = lo.x; vv.y = lo.y; vv.z = hi.x; vv.w = hi.y; bf16x8 vfrag = __builtin_bit_cast(bf16x8, vv);
                    o[df][0] = MFMA16(vfrag, pfr[0][k2], o[df][0]); o[df][1] = MFMA16(vfrag, pfr[1][k2], o[df][1]);
                }
        }
    }
#pragma unroll
    for (int qf = 0; qf < 2; ++qf) { const float inv = 1.0f / lrow[qf];
#pragma unroll
        for (int df = 0; df < DV / 16; ++df) o[df][qf] = o[df][qf] * inv; }
}

constexpr int ATT0_LAT = NB * NCL * 8, ATT0_CTX = NB * NCC * 8;
DEV void att0_item(const Params& p, char* smem, int it) {
    const bf16* PROJ = (const bf16*)(p.ws + WS_PROJ); bf16* CAT = (bf16*)(p.ws + WS_CAT);
    const bool isctx = it >= ATT0_LAT; if (isctx) it -= ATT0_LAT;
    const int nqb = isctx ? NCC : NCL; const int h = it % 8, qb = (it / 8) % nqb, b = it / (8 * nqb);
    const int qrow0 = isctx ? TL + b * CTX + qb * 128 : b * SEQ + qb * 128;
    const int lo = qb * 128 - 128 < 0 ? 0 : qb * 128 - 128, hi = qb * 128 + 256 > SEQ ? SEQ : qb * 128 + 256;
    f32x4 o[4][2];
    const bf16* Qp = PROJ + (size_t)qrow0 * LDP + 512 + h * 64; const bf16* Kb = PROJ + 1536 + (h / 4) * 64;
    const bf16* VTp = (const bf16*)(p.ws + WS_VT) + (size_t)(b * 2 + h / 4) * 64 * KVL; const float sink = p.in[I_ab_sink][h];
    if (isctx) flash_block<64, false>(smem, Qp, LDP, Kb, LDP, TL + b * CTX, b * SEQ, VTp, 0, CTX, 0, 0, 0, sink, 1.0f, o);
    else flash_block<64, true>(smem, Qp, LDP, Kb, LDP, TL + b * CTX, b * SEQ, VTp, 0, CTX, CTX + lo, CTX + hi, qb * 128, sink, 1.0f, o);
    const int lane = threadIdx.x & 63, w = threadIdx.x >> 6, fr = lane & 15, fq = lane >> 4;
#pragma unroll
    for (int qf = 0; qf < 2; ++qf)
#pragma unroll
        for (int df = 0; df < 4; ++df) st_bf16x4(CAT + (size_t)(qrow0 + w * 32 + qf * 16 + fr) * LDC + 512 + h * 64 + df * 16 + fq * 4, o[df][qf][0], o[df][qf][1], o[df][qf][2], o[df][qf][3]);
}
constexpr int ATT1_N = NB * NCL * 4;
DEV void att1_item(const Params& p, char* smem, int it) {
    const bf16* PROJ = (const bf16*)(p.ws + WS_PROJ); bf16* CAT = (bf16*)(p.ws + WS_CAT);
    const int h = it % 4, qb = (it / 4) % NCL, b = it / (4 * NCL); const int qrow0 = b * SEQ + qb * 128;
    const bf16* VTp = (const bf16*)(p.ws + WS_VT) + (size_t)(b * 4 + h) * 128 * KVL;
    f32x4 o0[8][2], o1[8][2];
    flash_block<128, false>(smem, PROJ + (size_t)qrow0 * LDP + h * 128, LDP, PROJ + 1024 + h * 128, LDP, TL + b * CTX, b * SEQ, VTp, 0, KVL, 0, 0, 0, -1e30f, 0.f, o0);
    u32x2* stash = (u32x2*)(smem + 27648) + threadIdx.x;
#pragma unroll
    for (int df = 0; df < 8; ++df)
#pragma unroll
        for (int qf = 0; qf < 2; ++qf) { u32x2 pk; pk.x = pk2(o0[df][qf][0], o0[df][qf][1]); pk.y = pk2(o0[df][qf][2], o0[df][qf][3]); stash[(df * 2 + qf) * 256] = pk; }
    flash_block<128, false>(smem, PROJ + (size_t)qrow0 * LDP + h * 128 + 64, LDP, PROJ + 1024 + h * 128 + 64, LDP, TL + b * CTX, b * SEQ, VTp, 0, KVL, 0, 0, 0, -1e30f, 0.f, o1);
    const float lam = ((const float*)(p.ws + WS_SCAL))[0], lam_init = ((const float*)(p.ws + WS_SCAL))[1];
    const int lane = threadIdx.x & 63, w = threadIdx.x >> 6, fr = lane & 15, fq = lane >> 4;
    const float* sg = p.in[I_cd_subln_g];
#pragma unroll
    for (int qf = 0; qf < 2; ++qf) {
        float ss = 0.f;
#pragma unroll
        for (int df = 0; df < 8; ++df) { u32x2 pk = stash[(df * 2 + qf) * 256]; o0[df][qf] = (f32x4){bflo(pk.x), bfhi(pk.x), bflo(pk.y), bfhi(pk.y)} - o1[df][qf] * lam;
#pragma unroll
            for (int j = 0; j < 4; ++j) ss += o0[df][qf][j] * o0[df][qf][j]; }
        ss += __shfl_xor(ss, 16); ss += __shfl_xor(ss, 32);
        const float sc = rsqrtf(ss * (1.0f / 128.0f) + EPS) * (1.0f - lam_init);
#pragma unroll
        for (int df = 0; df < 8; ++df) { f32x4 g = *(const f32x4*)(sg + df * 16 + fq * 4); f32x4 v = o0[df][qf] * sc * g;
            st_bf16x4(CAT + (size_t)(qrow0 + w * 32 + qf * 16 + fr) * LDC + h * 128 + df * 16 + fq * 4, v[0], v[1], v[2], v[3]); }
    }
}

constexpr int LRU_ITEMS = NB * LNT * LRUB;
DEV void lru_item(const Params& p, char* smem, int it, int pass) {
    const bf16* PROJ = (const bf16*)(p.ws + WS_PROJ); bf16* CAT = (bf16*)(p.ws + WS_CAT); float* AGG = (float*)(p.ws + WS_AGG);
    const int tid = threadIdx.x, lane = tid & 63, w = tid >> 6, fr = lane & 15, fq = lane >> 4;
    const int blk = it % LRUB, ck = (it / LRUB) % LNT, b = it / (LRUB * LNT);
    const bool isctx = ck < LNC; const int cs = isctx ? ck : ck - LNC;
    const int seglen = isctx ? CTX : SEQ; const int segrow0 = isctx ? TL + b * CTX : b * SEQ; const int t0 = cs * LCH;
    bf16* XA = (bf16*)smem;
    float* U = (float*)(smem + 4608);
    bf16* WT = (bf16*)(smem + 4608 + 8192);
    float* A_ = (float*)(smem + 4608 + 8192 + 18432);
    float* BX = A_ + 2 * LCH * 64;
    __syncthreads();
    for (int i = tid; i < (LCH + 3) * 8; i += 256) { int r = i >> 3, part = i & 7; int t = t0 - 1 + r; u32x4 v = (u32x4){0u, 0u, 0u, 0u};
        if (t >= 0 && t < seglen) v = *(const u32x4*)(PROJ + (size_t)(segrow0 + t) * LDP + 1024 + blk * 64 + part * 8);
        *(u32x4*)(XA + r * 64 + part * 8) = v; }
    __syncthreads();
    { const float* cw = p.in[I_ab_conv_w]; const float* cb = p.in[I_ab_conv_b];
      for (int i = tid; i < LCH * 64; i += 256) { int r = i >> 6, ch = i & 63, gc = blk * 64 + ch; float a = cb[gc];
#pragma unroll
          for (int j = 0; j < 4; ++j) a += cw[j * LRUW + gc] * bf2f(XA[(r + j) * 64 + ch]);
          U[i] = a; } }
    for (int d = 0; d < 2; ++d) {
        __syncthreads();
        for (int i = tid; i < 2 * 64 * 16; i += 256) { int g = i >> 10, c = (i >> 4) & 63, n4 = (i & 15) * 4;
            const float* W = (g ? p.in[I_ab_w_i] : p.in[I_ab_w_r]) + ((size_t)(d * LRUB + blk) * 64 + c) * 64 + n4; f32x4 v = *(const f32x4*)W;
#pragma unroll
            for (int j = 0; j < 4; ++j) WT[(g * 64 + n4 + j) * 72 + c] = (bf16)f2bf(v[j]); }
        __syncthreads();
        f32x4 ar[2], ai[2];
#pragma unroll
        for (int tf = 0; tf < 2; ++tf) { ar[tf] = (f32x4){0.f, 0.f, 0.f, 0.f}; ai[tf] = (f32x4){0.f, 0.f, 0.f, 0.f}; }
#pragma unroll
        for (int ks = 0; ks < 2; ++ks) {
            bf16x8 wr_ = *(const bf16x8*)(WT + (0 * 64 + w * 16 + fr) * 72 + ks * 32 + fq * 8), wi_ = *(const bf16x8*)(WT + (1 * 64 + w * 16 + fr) * 72 + ks * 32 + fq * 8);
#pragma unroll
            for (int tf = 0; tf < 2; ++tf) { const float* up = U + (tf * 16 + fr) * 64 + ks * 32 + fq * 8; f32x4 u0 = *(const f32x4*)up, u1 = *(const f32x4*)(up + 4);
                bf16x8 uf = pack8(u0[0], u0[1], u0[2], u0[3], u1[0], u1[1], u1[2], u1[3]);
                ar[tf] = MFMA16(wr_, uf, ar[tf]); ai[tf] = MFMA16(wi_, uf, ai[tf]); }
        }
#pragma unroll
        for (int tf = 0; tf < 2; ++tf)
#pragma unroll
            for (int j = 0; j < 4; ++j) { const int tok = tf * 16 + fr, ch = w * 16 + fq * 4 + j, gc = blk * 64 + ch;
                float r = sigmoidf_(ar[tf][j] + p.in[I_ab_b_r][d * LRUW + gc]), ig = sigmoidf_(ai[tf][j] + p.in[I_ab_b_i][d * LRUW + gc]);
                float sp = softplusf_(-p.in[I_ab_lam][d * LRUW + gc]); float la = -8.0f * r * sp; float a = __expf(la);
                float u = U[tok * 64 + ch]; float bx = sqrtf(fmaxf(1.0f - a * a, 0.f)) * ig * u;
                A_[(d * LCH + tok) * 64 + ch] = a; BX[(d * LCH + tok) * 64 + ch] = bx; }
    }
    __syncthreads();
    if (tid < 128) { const int d = tid >> 6, ch = tid & 63, gc = blk * 64 + ch;
        float h = 0.f;
        if (pass == 2) {
            if (d == 0) { for (int c2 = 0; c2 < ck; ++c2) { const float* ag = AGG + ((size_t)(b * LNT + c2) * 2 + 0) * 1024; h = ag[gc] * h + ag[512 + gc]; } }
            else { if (isctx) { for (int c2 = LNC - 1; c2 > ck; --c2) { const float* ag = AGG + ((size_t)(b * LNT + c2) * 2 + 1) * 1024; h = ag[gc] * h + ag[512 + gc]; } }
                   else { for (int c2 = LNC - 1; c2 >= 0; --c2) { const float* ag = AGG + ((size_t)(b * LNT + c2) * 2 + 1) * 1024; h = ag[gc] * h + ag[512 + gc]; }
                          for (int c2 = LNT - 1; c2 > ck; --c2) { const float* ag = AGG + ((size_t)(b * LNT + c2) * 2 + 1) * 1024; h = ag[gc] * h + ag[512 + gc]; } } }
        }
        float ap = 1.f;
        for (int i = 0; i < LCH; ++i) { const int tok = d ? LCH - 1 - i : i; float a = A_[(d * LCH + tok) * 64 + ch], bx = BX[(d * LCH + tok) * 64 + ch]; h = a * h + bx; ap *= a; BX[(d * LCH + tok) * 64 + ch] = h; }
        if (pass == 1) { float* ag = AGG + ((size_t)(b * LNT + ck) * 2 + d) * 1024; ag[gc] = ap; ag[512 + gc] = h; }
    }
    if (pass == 2) {
        __syncthreads();
        for (int i = tid; i < LCH * 16; i += 256) { int r = i >> 4, c4 = (i & 15) * 4; const size_t row = (size_t)(segrow0 + t0 + r);
            u32x2 gg = *(const u32x2*)(PROJ + row * LDP + blk * 64 + c4);
            const float* h0 = BX + (0 * LCH + r) * 64 + c4; const float* h1 = BX + (1 * LCH + r) * 64 + c4;
            st_bf16x4(CAT + row * LDC + blk * 64 + c4, (h0[0] + h1[0]) * bflo(gg.x), (h0[1] + h1[1]) * bfhi(gg.x), (h0[2] + h1[2]) * bflo(gg.y), (h0[3] + h1[3]) * bfhi(gg.y)); }
    }
}

DEV void router_item(const Params& p, char* smem, int it, int l, int ntok) {
    const int tid = threadIdx.x, lane = tid & 63, w = tid >> 6;
    float* HS = (float*)smem + w * 2 * DM;
    const float* X = (const float*)(p.ws + WS_X); bf16* H = (bf16*)(p.ws + WS_HA);
    unsigned* CNT = (unsigned*)(p.ws + WS_CTL) + CW_CNT + l * (NE + 1);
    const int t0 = it * 8 + w * 2;
    __syncthreads();
#pragma unroll
    for (int u = 0; u < 2; ++u) { const int t = t0 + u; if (t < ntok) {
        f32x4 v[NV], h[NV]; load_row(X + (size_t)t * DM, lane, v); float rstd = row_rstd(v);
        norm_mod(v, rstd, p.in[I_g_ffn] + l * DM, modp(p, l, t, 3), modp(p, l, t, 4), lane, h);
        store_row_bf16(H + (size_t)t * DM, lane, h);
#pragma unroll
        for (int i = 0; i < NV; ++i) *(f32x4*)(HS + u * DM + i * 256 + lane * 4) = h[i]; } }
    __syncthreads();
    const float* Wr = p.in[I_w_router] + (size_t)l * DM * NE;
    float lg0 = 0.f, lg1 = 0.f; const int e = lane < NE ? lane : 0;
#pragma unroll 8
    for (int k = 0; k < DM; ++k) { float wv = Wr[(size_t)k * NE + e]; lg0 += HS[k] * wv; lg1 += HS[DM + k] * wv; }
#pragma unroll
    for (int u = 0; u < 2; ++u) { const int t = t0 + u; const bool tv = t < ntok;
        const float sc = sigmoidf_(u ? lg1 : lg0); const bool ev = lane < NE;
        const float sel = ev ? sc + p.in[I_b_router][l * NE + e] : -3e38f;
        int rk = 0;
#pragma unroll
        for (int d = 1; d < PER; ++d) { float o = __shfl_xor(sel, d); int j = lane ^ d; rk += (o > sel || (o == sel && j < lane)) ? 1 : 0; }
        float gs = rk < 2 ? sel : 0.f;
#pragma unroll
        for (int d = 1; d < PER; d <<= 1) gs += __shfl_xor(gs, d);
        if (!ev) gs = -3e38f;
        int grk = 0; const int g = lane / PER;
#pragma unroll
        for (int d = 1; d < 8; ++d) { float o = __shfl_xor(gs, (d * PER) & 63); int gj = g ^ d; if (PER * 8 == 64 || (lane ^ (d * PER)) < NE) grk += (o > gs || (o == gs && gj < g)) ? 1 : 0; }
        const float v = (ev && grk < 4) ? sel : -3e38f;
        int erk = 0;
        for (int d = 1; d < 64; ++d) { float o = __shfl_xor(v, d); int j = lane ^ d; erk += (o > v || (o == v && j < lane)) ? 1 : 0; }
        const bool chosen = ev && grk < 4 && erk < 8;
        float gsum = wave_sum(chosen ? sc : 0.f);
        if (tv && chosen) { const float gate = sc / gsum * 2.5f; unsigned pos = atomicAdd(&CNT[lane], 1u);
            ((int*)(p.ws + WS_LIST))[(size_t)lane * TT + pos] = t; ((float*)(p.ws + WS_LISTW))[(size_t)lane * TT + pos] = gate;
            ((int*)(p.ws + WS_REF))[(size_t)t * 8 + erk] = (int)((pos << 8) | (unsigned)lane); }
    }
}

DEV void moe_prefix(const Params& p, char* smem, int l, int ntok) {
    int* TOFF = (int*)(smem + 16384); int* SOFF = TOFF + 80;
    const unsigned* CNT = (const unsigned*)(p.ws + WS_CTL) + CW_CNT + l * (NE + 1);
    __syncthreads();
    if (threadIdx.x == 0) { int ta = 0, sa = 0; for (int e = 0; e <= NE; ++e) { int c = e < NE ? (int)CNT[e] : ntok; TOFF[e] = ta; SOFF[e] = sa; ta += (c + 127) / 128; sa += c; } TOFF[NE + 1] = ta; SOFF[NE + 1] = sa; }
    __syncthreads();
}
DEV void moe_find(const int* TOFF, int tile, int& e, int& mt) { int lo = 0; for (int k = 0; k <= NE; ++k) if (TOFF[k] <= tile) lo = k; e = lo; mt = tile - TOFF[lo]; }
DEV void moe_g1_phase(const Params& p, char* smem, int l, int ntok) {
    moe_prefix(p, smem, l, ntok);
    const int* TOFF = (const int*)(smem + 16384); const int* SOFF = TOFF + 80;
    constexpr int NNT = DE / 64; const int ntiles = TOFF[NE + 1];
    const unsigned* CNT = (const unsigned*)(p.ws + WS_CTL) + CW_CNT + l * (NE + 1);
    for (int it = blockIdx.x; it < ntiles * NNT; it += gridDim.x) {
        const int tile = it % ntiles, nt = it / ntiles; int e, mt; moe_find(TOFF, tile, e, mt);
        const int cnt = e < NE ? (int)CNT[e] : ntok; const int nvalid = cnt - mt * 128 < 128 ? cnt - mt * 128 : 128;
        GemmA a{(const bf16*)(p.ws + WS_HA), DM, e < NE ? (const int*)(p.ws + WS_LIST) + (size_t)e * TT + mt * 128 : nullptr, mt * 128, nvalid};
        const float* wg = e < NE ? p.in[I_w_e_gate] + ((size_t)l * NE + e) * DM * DE : p.in[I_ws_gate] + (size_t)l * DM * DE;
        const float* wu = e < NE ? p.in[I_w_e_up] + ((size_t)l * NE + e) * DM * DE : p.in[I_ws_up] + (size_t)l * DM * DE;
        GemmB bb{wg, wu, DE, nt * 64, DE, 1, DM};
        EpiG1 epi{(bf16*)(p.ws + WS_ACT), SOFF[e] + mt * 128, nvalid, nt * 64};
        gemm_tile(smem, a, bb, epi);
    }
}
DEV void moe_g2_phase(const Params& p, char* smem, int l, int ntok) {
    moe_prefix(p, smem, l, ntok);
    const int* TOFF = (const int*)(smem + 16384); const int* SOFF = TOFF + 80;
    constexpr int NNT = DM / 128; const int ntiles = TOFF[NE + 1];
    const unsigned* CNT = (const unsigned*)(p.ws + WS_CTL) + CW_CNT + l * (NE + 1);
    for (int it = blockIdx.x; it < ntiles * NNT; it += gridDim.x) {
        const int tile = it % ntiles, nt = it / ntiles; int e, mt; moe_find(TOFF, tile, e, mt);
        const int cnt = e < NE ? (int)CNT[e] : ntok; const int nvalid = cnt - mt * 128 < 128 ? cnt - mt * 128 : 128;
        GemmA a{(const bf16*)(p.ws + WS_ACT), DE, nullptr, SOFF[e] + mt * 128, nvalid};
        const float* wd = e < NE ? p.in[I_w_e_down] + ((size_t)l * NE + e) * DE * DM : p.in[I_ws_down] + (size_t)l * DE * DM;
        GemmB bb{wd, nullptr, DM, nt * 128, DM, 0, DE};
        EpiG2 epi{(bf16*)(p.ws + WS_Y), SOFF[e] + mt * 128, nvalid, nt * 128, e < NE ? (const float*)(p.ws + WS_LISTW) + (size_t)e * TT + mt * 128 : nullptr};
        gemm_tile(smem, a, bb, epi);
    }
}
DEV void combine_phase(const Params& p, char* smem, int l, int ntok) {
    moe_prefix(p, smem, l, ntok);
    const int* SOFF = (const int*)(smem + 16384) + 80;
    const int lane = threadIdx.x & 63; float* X = (float*)(p.ws + WS_X); const bf16* Y = (const bf16*)(p.ws + WS_Y); const int* REF = (const int*)(p.ws + WS_REF);
    for (int it = blockIdx.x; it < ntok / 4; it += gridDim.x) {
        const int t = it * 4 + (threadIdx.x >> 6);
        f32x4 acc[NV];
#pragma unroll
        for (int i = 0; i < NV; ++i) acc[i] = (f32x4){0.f, 0.f, 0.f, 0.f};
#pragma unroll
        for (int k = 0; k < 9; ++k) { int slot; if (k < 8) { int r = REF[(size_t)t * 8 + k]; slot = SOFF[r & 255] + (int)((unsigned)r >> 8); } else slot = SOFF[NE] + t;
            const bf16* yr = Y + (size_t)slot * DM;
#pragma unroll
            for (int i = 0; i < NV; ++i) { u32x2 u = *(const u32x2*)(yr + i * 256 + lane * 4); acc[i][0] += bflo(u.x); acc[i][1] += bfhi(u.x); acc[i][2] += bflo(u.y); acc[i][3] += bfhi(u.y); } }
        f32x4 v[NV]; load_row(X + (size_t)t * DM, lane, v); const float* g2 = modp(p, l, t, 5);
#pragma unroll
        for (int i = 0; i < NV; ++i) { f32x4 g = *(const f32x4*)(g2 + i * 256 + lane * 4); v[i] = v[i] + g * acc[i]; }
        const float rstd = row_rstd(v);
        if (l == 0) {
#pragma unroll
            for (int i = 0; i < NV; ++i) *(f32x4*)(X + (size_t)t * DM + i * 256 + lane * 4) = v[i];
            f32x4 h[NV]; norm_mod(v, rstd, p.in[I_g_mix] + DM, modp(p, 1, t, 0), modp(p, 1, t, 1), lane, h);
            store_row_bf16((bf16*)(p.ws + WS_HB) + (size_t)t * DM, lane, h);
        } else {
#pragma unroll
            for (int i = 0; i < NV; ++i) { f32x4 g = *(const f32x4*)(p.in[I_g_final] + i * 256 + lane * 4); *(f32x4*)(p.out + (size_t)t * DM + i * 256 + lane * 4) = v[i] * rstd * g; }
        }
    }
}

constexpr int CONV_ITEMS = TT / 32;
DEV void ssdconv_item(const Params& p, int it) {
    const bf16* PROJ = (const bf16*)(p.ws + WS_PROJ); bf16* U = (bf16*)(p.ws + WS_U); float* DTV = (float*)(p.ws + WS_DTV);
    const int tid = threadIdx.x; const int row0 = it * 32; const bool lat = row0 < TL;
    const int seglen = lat ? SEQ : CTX; const int segrow0 = lat ? (row0 / SEQ) * SEQ : TL + ((row0 - TL) / CTX) * CTX; const int t0 = row0 - segrow0;
    const int c4 = tid * 4; f32x4 w[4], bb = *(const f32x4*)(p.in[I_cd_conv_b] + c4);
#pragma unroll
    for (int j = 0; j < 4; ++j) w[j] = *(const f32x4*)(p.in[I_cd_conv_w] + j * 1024 + c4);
    f32x4 win[4];
    auto ldrow = [&](int t) -> f32x4 { if (t < 0 || t >= seglen) return (f32x4){0.f, 0.f, 0.f, 0.f}; u32x2 u = *(const u32x2*)(PROJ + (size_t)(segrow0 + t) * LDP + 2048 + c4); return (f32x4){bflo(u.x), bfhi(u.x), bflo(u.y), bfhi(u.y)}; };
    win[0] = ldrow(t0 - 1); win[1] = ldrow(t0); win[2] = ldrow(t0 + 1);
    for (int r = 0; r < 32; ++r) { win[3] = ldrow(t0 + r + 2);
        f32x4 a = bb + w[0] * win[0] + w[1] * win[1] + w[2] * win[2] + w[3] * win[3];
        st_bf16x4(U + (size_t)(row0 + r) * 1024 + c4, siluf_(a[0]), siluf_(a[1]), siluf_(a[2]), siluf_(a[3]));
        win[0] = win[1]; win[1] = win[2]; win[2] = win[3]; }
    for (int i = tid; i < 32 * 16; i += 256) { int r = i >> 4, c = i & 15; float raw = bf2f(PROJ[(size_t)(row0 + r) * LDP + 3072 + c]);
        DTV[(size_t)(row0 + r) * 16 + c] = softplusf_(raw + p.in[I_cd_dt_bias][c]); }
}
DEV int ssd_chunk_row0(int b, int c) { return c < NCC ? TL + b * CTX + c * 128 : b * SEQ + (c - NCC) * 128; }
constexpr int TSTR = 136;
constexpr int SSD1_ITEMS = NB * NCH * 8;
DEV void ssd1_item(const Params& p, char* smem, int it) {
    const bf16* U = (const bf16*)(p.ws + WS_U); const float* DTV = (const float*)(p.ws + WS_DTV);
    const int tid = threadIdx.x, lane = tid & 63, w = tid >> 6, fr = lane & 15, fq = lane >> 4;
    const int h = it % 8, c = (it / 8) % NCH, b = it / (8 * NCH), g = h / 4; const int row0 = ssd_chunk_row0(b, c);
    bf16* XT = (bf16*)smem;
    bf16* BT = XT + 2 * 64 * TSTR;
    float* WGT = (float*)(BT + 128 * TSTR);
    __syncthreads();
    if (tid < 128) { const int d = tid >> 6;
        const float a = -__expf(p.in[I_cd_a_log][d * 8 + h]); const int l0 = lane * 2;
        float dt0 = DTV[(size_t)(row0 + l0) * 16 + d * 8 + h], dt1 = DTV[(size_t)(row0 + l0 + 1) * 16 + d * 8 + h];
        float s = (dt0 + dt1) * a, incl = s;
#pragma unroll
        for (int o = 1; o < 64; o <<= 1) { float v = __shfl_up(incl, o); if (lane >= o) incl += v; }
        const float total = __shfl(incl, 63); const float ex = incl - s;
        if (d == 0) { WGT[l0] = __expf(total - (ex + dt0 * a)) * dt0; WGT[l0 + 1] = __expf(total - incl) * dt1; }
        else { WGT[128 + l0] = __expf(ex) * dt0; WGT[128 + l0 + 1] = __expf(ex + dt0 * a) * dt1; }
        if (lane == 0) ((float*)(p.ws + WS_DEC))[((size_t)(b * NCH + c) * 2 + d) * 8 + h] = __expf(total);
    }
    __syncthreads();
    for (int i = tid; i < 128 * 8; i += 256) { int l = i >> 3, part = i & 7; u32x4 v = *(const u32x4*)(U + (size_t)(row0 + l) * 1024 + h * 64 + part * 8); const float wf = WGT[l], wv = WGT[128 + l];
        unsigned uu[4] = {v.x, v.y, v.z, v.w};
#pragma unroll
        for (int j = 0; j < 8; ++j) { float x = (j & 1) ? bfhi(uu[j >> 1]) : bflo(uu[j >> 1]); int pp = part * 8 + j; XT[(0 * 64 + pp) * TSTR + l] = (bf16)f2bf(x * wf); XT[(1 * 64 + pp) * TSTR + l] = (bf16)f2bf(x * wv); } }
    for (int i = tid; i < 128 * 16; i += 256) { int l = i >> 4, part = i & 15; u32x4 v = *(const u32x4*)(U + (size_t)(row0 + l) * 1024 + 512 + g * 128 + part * 8);
        unsigned uu[4] = {v.x, v.y, v.z, v.w};
#pragma unroll
        for (int j = 0; j < 8; ++j) BT[(part * 8 + j) * TSTR + l] = (bf16)((j & 1) ? (uu[j >> 1] >> 16) : (uu[j >> 1] & 0xffffu)); }
    __syncthreads();
    float* ST = (float*)(p.ws + WS_ST);
#pragma unroll 1
    for (int d = 0; d < 2; ++d) {
        f32x4 acc[8];
#pragma unroll
        for (int nf = 0; nf < 8; ++nf) acc[nf] = (f32x4){0.f, 0.f, 0.f, 0.f};
#pragma unroll
        for (int ks = 0; ks < 4; ++ks) { bf16x8 xa = *(const bf16x8*)(XT + (d * 64 + w * 16 + fr) * TSTR + ks * 32 + fq * 8);
#pragma unroll
            for (int nf = 0; nf < 8; ++nf) { bf16x8 bfm = *(const bf16x8*)(BT + (nf * 16 + fr) * TSTR + ks * 32 + fq * 8); acc[nf] = MFMA16(xa, bfm, acc[nf]); } }
        float* st = ST + (((size_t)(b * NCH + c) * 2 + d) * 8 + h) * 8192;
#pragma unroll
        for (int nf = 0; nf < 8; ++nf)
#pragma unroll
            for (int j = 0; j < 4; ++j) st[(w * 16 + fq * 4 + j) * 128 + nf * 16 + fr] = acc[nf][j];
    }
}
constexpr int SSD2_ITEMS = NB * 2 * 8 * 4;
DEV void ssd2_item(const Params& p, int it) {
    float* ST = (float*)(p.ws + WS_ST); const float* DEC = (const float*)(p.ws + WS_DEC);
    const int q = it & 3, h = (it >> 2) & 7, d = (it >> 5) & 1, b = it >> 6; const int e0 = q * 2048 + threadIdx.x * 8;
    f32x4 c0 = (f32x4){0.f, 0.f, 0.f, 0.f}, c1 = c0;
    for (int i = 0; i < NCH; ++i) { int c = d == 0 ? i : (i < NCC ? NCC - 1 - i : NCH - 1 - (i - NCC));
        float* st = ST + (((size_t)(b * NCH + c) * 2 + d) * 8 + h) * 8192 + e0; const float dec = DEC[((size_t)(b * NCH + c) * 2 + d) * 8 + h];
        f32x4 s0 = *(f32x4*)st, s1 = *(f32x4*)(st + 4);
        if (c >= NCC) { *(f32x4*)st = c0; *(f32x4*)(st + 4) = c1; }
        c0 = c0 * dec + s0; c1 = c1 * dec + s1; }
}
constexpr int SSD3_ITEMS = NB * NCL * 4;
DEV void ssd3_item(const Params& p, char* smem, int it) {
    const bf16* U = (const bf16*)(p.ws + WS_U); const float* DTV = (const float*)(p.ws + WS_DTV); const bf16* PROJ = (const bf16*)(p.ws + WS_PROJ); bf16* CAT = (bf16*)(p.ws + WS_CAT);
    const float* ST = (const float*)(p.ws + WS_ST);
    const int tid = threadIdx.x, lane = tid & 63, w = tid >> 6, fr = lane & 15, fq = lane >> 4;
    const int hf = it & 1, g = (it >> 1) & 1, cl = (it >> 2) % NCL, b = it / (4 * NCL); const int c = NCC + cl; const int row0 = b * SEQ + cl * 128;
    const int LF = hf * 4 + w; const int l = LF * 16 + fr;
    bf16* CS = (bf16*)smem;
    bf16* R2 = CS + 128 * TSTR;
    bf16* XT = R2; bf16* HB = R2 + 64 * TSTR;
    float* AC = (float*)(R2 + 128 * TSTR);
    float* DT = AC + 256;
    __syncthreads();
    for (int i = tid; i < 128 * 16; i += 256) { int ll = i >> 4, part = i & 15;
        *(u32x4*)(CS + ll * TSTR + part * 8) = *(const u32x4*)(U + (size_t)(row0 + ll) * 1024 + 768 + g * 128 + part * 8);
        *(u32x4*)(R2 + ll * TSTR + part * 8) = *(const u32x4*)(U + (size_t)(row0 + ll) * 1024 + 512 + g * 128 + part * 8); }
    __syncthreads();
    f32x4 cbt[8];
#pragma unroll
    for (int sf = 0; sf < 8; ++sf) cbt[sf] = (f32x4){0.f, 0.f, 0.f, 0.f};
#pragma unroll
    for (int ks = 0; ks < 4; ++ks) { bf16x8 cf = *(const bf16x8*)(CS + l * TSTR + ks * 32 + fq * 8);
#pragma unroll
        for (int sf = 0; sf < 8; ++sf) { bf16x8 bfm = *(const bf16x8*)(R2 + (sf * 16 + fr) * TSTR + ks * 32 + fq * 8); cbt[sf] = MFMA16(bfm, cf, cbt[sf]); } }
    float ss = 0.f; const size_t row = (size_t)(row0 + l);
#pragma unroll 1
    for (int hh = 0; hh < 4; ++hh) {
        const int h = g * 4 + hh;
        __syncthreads();
        if (tid < 128) { const int d = tid >> 6; const float a = -__expf(p.in[I_cd_a_log][d * 8 + h]); const int l0 = lane * 2;
            float dt0 = DTV[(size_t)(row0 + l0) * 16 + d * 8 + h], dt1 = DTV[(size_t)(row0 + l0 + 1) * 16 + d * 8 + h];
            float s2 = (dt0 + dt1) * a, incl = s2;
#pragma unroll
            for (int o = 1; o < 64; o <<= 1) { float v = __shfl_up(incl, o); if (lane >= o) incl += v; }
            const float total = __shfl(incl, 63), ex = incl - s2;
            if (d == 0) { AC[l0] = ex + dt0 * a; AC[l0 + 1] = incl; } else { AC[128 + l0] = total - ex; AC[128 + l0 + 1] = total - ex - dt0 * a; }
            DT[d * 128 + l0] = dt0; DT[d * 128 + l0 + 1] = dt1; }
        for (int i = tid; i < 128 * 8; i += 256) { int ll = i >> 3, part = i & 7; u32x4 v = *(const u32x4*)(U + (size_t)(row0 + ll) * 1024 + h * 64 + part * 8);
            unsigned uu[4] = {v.x, v.y, v.z, v.w};
#pragma unroll
            for (int j = 0; j < 8; ++j) XT[(part * 8 + j) * TSTR + ll] = (bf16)((j & 1) ? (uu[j >> 1] >> 16) : (uu[j >> 1] & 0xffffu)); }
        __syncthreads();
        f32x4 y[4];
#pragma unroll
        for (int pf = 0; pf < 4; ++pf) y[pf] = (f32x4){0.f, 0.f, 0.f, 0.f};
#pragma unroll
        for (int k2 = 0; k2 < 4; ++k2) {
#pragma unroll 1
            for (int d = 0; d < 2; ++d) {
                const float acl = AC[d * 128 + l]; float wv[8];
#pragma unroll
                for (int jj = 0; jj < 8; ++jj) { const int s = (2 * k2 + (jj >> 2)) * 16 + fq * 4 + (jj & 3);
                    const bool ok = d == 0 ? s <= l : s >= l; const float arg = ok ? acl - AC[d * 128 + s] : -1e30f;
                    wv[jj] = cbt[2 * k2 + (jj >> 2)][jj & 3] * __expf(arg) * DT[d * 128 + s]; }
                bf16x8 wfr = pack8(wv[0], wv[1], wv[2], wv[3], wv[4], wv[5], wv[6], wv[7]);
#pragma unroll
                for (int pf = 0; pf < 4; ++pf) { u32x2 lo = *(const u32x2*)(XT + (pf * 16 + fr) * TSTR + k2 * 32 + fq * 4), hi = *(const u32x2*)(XT + (pf * 16 + fr) * TSTR + k2 * 32 + 16 + fq * 4);
                    u32x4 vv; vv.x = lo.x; vv.y = lo.y; vv.z = hi.x; vv.w = hi.y; bf16x8 xf = __builtin_bit_cast(bf16x8, vv);
                    y[pf] = MFMA16(xf, wfr, y[pf]); }
            }
        }
        { const float dsk = p.in[I_cd_d_skip][h];
#pragma unroll
          for (int pf = 0; pf < 4; ++pf)
#pragma unroll
              for (int j = 0; j < 4; ++j) y[pf][j] += dsk * bf2f(XT[(pf * 16 + fq * 4 + j) * TSTR + l]); }
#pragma unroll 1
        for (int d = 0; d < 2; ++d) {
            __syncthreads();
            const float* hin = ST + (((size_t)(b * NCH + c) * 2 + d) * 8 + h) * 8192;
            for (int i = tid; i < 64 * 32; i += 256) { int pp = i >> 5, n4 = (i & 31) * 4; f32x4 v = *(const f32x4*)(hin + pp * 128 + n4); st_bf16x4(HB + pp * TSTR + n4, v[0], v[1], v[2], v[3]); }
            __syncthreads();
            f32x4 tt[4];
#pragma unroll
            for (int pf = 0; pf < 4; ++pf) tt[pf] = (f32x4){0.f, 0.f, 0.f, 0.f};
#pragma unroll
            for (int ks = 0; ks < 4; ++ks) { bf16x8 cf = *(const bf16x8*)(CS + l * TSTR + ks * 32 + fq * 8);
#pragma unroll
                for (int pf = 0; pf < 4; ++pf) { bf16x8 hfm = *(const bf16x8*)(HB + (pf * 16 + fr) * TSTR + ks * 32 + fq * 8); tt[pf] = MFMA16(hfm, cf, tt[pf]); } }
            const float sc = __expf(AC[d * 128 + l]);
#pragma unroll
            for (int pf = 0; pf < 4; ++pf) y[pf] = y[pf] + tt[pf] * sc;
        }
#pragma unroll
        for (int pf = 0; pf < 4; ++pf) { u32x2 z = *(const u32x2*)(PROJ + row * LDP + 512 + h * 64 + pf * 16 + fq * 4);
            float v0 = y[pf][0] * siluf_(bflo(z.x)), v1 = y[pf][1] * siluf_(bfhi(z.x)), v2 = y[pf][2] * siluf_(bflo(z.y)), v3 = y[pf][3] * siluf_(bfhi(z.y));
            ss += v0 * v0 + v1 * v1 + v2 * v2 + v3 * v3; st_bf16x4(CAT + row * LDC + 512 + h * 64 + pf * 16 + fq * 4, v0, v1, v2, v3); }
    }
    ss += __shfl_xor(ss, 16); ss += __shfl_xor(ss, 32); const float rstd = rsqrtf(ss * (1.0f / 256.0f) + EPS);
#pragma unroll 1
    for (int hh = 0; hh < 4; ++hh)
#pragma unroll
        for (int pf = 0; pf < 4; ++pf) { const int ch = g * 256 + hh * 64 + pf * 16 + fq * 4; f32x4 ng = *(const f32x4*)(p.in[I_cd_norm_g] + ch); u32x2 pk = *(const u32x2*)(CAT + row * LDC + 512 + ch);
            st_bf16x4(CAT + row * LDC + 512 + ch, bflo(pk.x) * rstd * ng[0], bfhi(pk.x) * rstd * ng[1], bflo(pk.y) * rstd * ng[2], bfhi(pk.y) * rstd * ng[3]); }
}

#ifndef HIP_EMU
namespace cg = cooperative_groups;
#define XB_TMO      128
#define XB_XCNT(j)  (256  + 64 * (j))
#define XB_XSUB(j)  (1280 + 64 * (j))
#define XB_XGEN(j)  (2304 + 64 * (j))
#define XB_TOP      3328
#define XB_TOPGEN   3392
#define XCD_BAR_WORDS 3456
#define XB_SPIN_CAP (1u << 20)
DEV unsigned xb_ld(unsigned* p) { return __hip_atomic_load(p, __ATOMIC_RELAXED, __HIP_MEMORY_SCOPE_AGENT); }
DEV unsigned xb_add(unsigned* p, unsigned v) { return __hip_atomic_fetch_add(p, v, __ATOMIC_RELAXED, __HIP_MEMORY_SCOPE_AGENT); }
DEV unsigned xb_xcc_id() { return (unsigned)__builtin_amdgcn_s_getreg((3 << 11) | 20) & 0xFu; }
#define XB_SPIN(cond, bar) do { unsigned _sp = 0; while (cond) { __builtin_amdgcn_s_sleep(1); \
    if ((++_sp & 255u) == 0u) { if (xb_ld(&(bar)[XB_TMO])) break; if (_sp > XB_SPIN_CAP) { atomicAdd(&(bar)[XB_TMO], 1u); break; } } } } while (0)
struct XcdBarrier { unsigned* bar; unsigned x; unsigned* st; };
DEV void xcd_barrier_complete(unsigned* bar, unsigned x, unsigned& nloc, unsigned& nx) {
    const unsigned G = gridDim.x; unsigned sum, cnt, mine, sp = 0u;
    for (;;) { sum = 0u; cnt = 0u; mine = 0u;
#pragma unroll
        for (unsigned j = 0; j < 16; ++j) { const unsigned c = xb_ld(&bar[XB_XCNT(j)]); sum += c; cnt += (c > 0u) ? 1u : 0u; mine = (j == x) ? c : mine; }
        if (sum == G) break;
        __builtin_amdgcn_s_sleep(1);
        if ((++sp & 255u) == 0u) { if (xb_ld(&bar[XB_TMO])) break; if (sp > XB_SPIN_CAP) { atomicAdd(&bar[XB_TMO], 1u); break; } } }
    nloc = mine > 0u ? mine : 1u; nx = cnt > 0u ? cnt : 1u;
}
DEV void xcd_barrier(const XcdBarrier& b) {
    asm volatile("s_waitcnt vmcnt(0)" ::: "memory");
    __syncthreads();
    if (threadIdx.x == 0) {
        unsigned* bar = b.bar;
        __builtin_amdgcn_s_waitcnt(0);
        unsigned nloc = b.st[0], nx = b.st[1];
        if (nloc == 0u) { xcd_barrier_complete(bar, b.x, nloc, nx); b.st[0] = nloc; b.st[1] = nx; }
        const unsigned old = xb_add(&bar[XB_XSUB(b.x)], 1u);
        const unsigned gen = old / nloc;
        if (old + 1u == (gen + 1u) * nloc) {
            __builtin_amdgcn_fence(__ATOMIC_RELEASE, "agent");
            asm volatile("s_waitcnt vmcnt(0)" ::: "memory");
            const unsigned og = xb_add(&bar[XB_TOP], 1u);
            const unsigned tg = og / nx;
            if (og + 1u == (tg + 1u) * nx) xb_add(&bar[XB_TOPGEN], 1u);
            else XB_SPIN(xb_ld(&bar[XB_TOPGEN]) == tg, bar);
            __builtin_amdgcn_fence(__ATOMIC_ACQUIRE, "agent");
            xb_add(&bar[XB_XGEN(b.x)], 1u);
            asm volatile("s_waitcnt vmcnt(0)" ::: "memory");
        } else {
            XB_SPIN(xb_ld(&bar[XB_XGEN(b.x)]) == gen, bar);
            __builtin_amdgcn_fence(__ATOMIC_ACQUIRE, "agent");
            asm volatile("s_waitcnt vmcnt(0)" ::: "memory");
        }
    }
    __syncthreads();
}
#endif

#ifdef ONLY_PHASE
#define PH(k) ((k) == ONLY_PHASE)
#else
#define PH(k) true
#endif
__global__ void __launch_bounds__(256, 2) mega(Params p) {
#ifdef HIP_EMU
    char* smem = emu_smem();
#define GRID_SYNC() emu_grid_sync()
#else
    __shared__ __attribute__((aligned(16))) char smem[SMEM_BYTES];
    __shared__ __attribute__((aligned(16))) unsigned bar_st[4];
    if (threadIdx.x < 4) bar_st[threadIdx.x] = 0u;
    __syncthreads();
    XcdBarrier xb; xb.bar = (unsigned*)(p.ws + WS_CTL); xb.x = xb_xcc_id(); xb.st = bar_st;
    if (threadIdx.x == 0) (void)xb_add(&xb.bar[XB_XCNT(xb.x)], 1u);
#define GRID_SYNC() xcd_barrier(xb)
#endif
    const int G = gridDim.x, B0 = blockIdx.x;
    if (PH(0)) for (int it = B0; it < 2 * MOD_CG + SEQ * 32 / 256 + 1; it += G) {
        if (it < 2 * MOD_CG) mod_item(p, smem, it); else if (it < 2 * MOD_CG + SEQ * 32 / 256) rope_item(p, it - 2 * MOD_CG); else lam_item(p);
    }
#ifdef HIP_EMU
    GRID_SYNC();
#else
    cg::this_grid().sync();
#endif
    if (PH(1)) for (int it = B0; it < TT / 4; it += G) norm0_item(p, it);
    GRID_SYNC();
    if (PH(2)) {   constexpr int NNT = AB_IN / 128;
        for (int it = B0; it < (TT / 128) * NNT; it += G) { const int mt = it % (TT / 128), nt = it / (TT / 128); const int n0 = nt * 128;
            GemmA a{(const bf16*)(p.ws + WS_HA), DM, nullptr, mt * 128, 128}; GemmB bb{p.in[I_ab_w_in], nullptr, AB_IN, n0, AB_IN, 0, DM};
            const int ct = n0 < 512 ? CT_GELU : n0 < 1024 ? CT_ROPE_SCALE : n0 < 1536 ? CT_RAW : n0 < 1664 ? CT_ROPE : CT_VT;
            EpiProj epi{&p, mt * 128, n0, AB_IN, ct, 1664, 64, 2}; gemm_tile(smem, a, bb, epi); } }
    GRID_SYNC();
    if (PH(3)) for (int it = B0; it < ATT0_LAT + ATT0_CTX; it += G) att0_item(p, smem, it);
    if (PH(4)) for (int it = B0; it < LRU_ITEMS; it += G) lru_item(p, smem, it, 1);
    GRID_SYNC();
    if (PH(5)) for (int it = B0; it < LRU_ITEMS; it += G) lru_item(p, smem, it, 2);
    GRID_SYNC();
    if (PH(6)) for (int it = B0; it < (TT / 128) * (DM / 128); it += G) { const int mt = it % (TT / 128), nt = it / (TT / 128);
        GemmA a{(const bf16*)(p.ws + WS_CAT), LDC, nullptr, mt * 128, 128}; GemmB bb{p.in[I_ab_w_out], nullptr, DM, nt * 128, DM, 0, 1024};
        EpiOut epi{&p, mt * 128, nt * 128, 0}; gemm_tile(smem, a, bb, epi); }
    GRID_SYNC();
    if (PH(7)) for (int it = B0; it < (TT + 7) / 8; it += G) router_item(p, smem, it, 0, TT);
    GRID_SYNC();
    if (PH(8)) moe_g1_phase(p, smem, 0, TT);
    GRID_SYNC();
    if (PH(9)) moe_g2_phase(p, smem, 0, TT);
    GRID_SYNC();
    if (PH(10)) combine_phase(p, smem, 0, TT);
    GRID_SYNC();
    if (PH(11)) {   constexpr int NNT = (CD_IN + 127) / 128, MTL = TL / 128, MTC = TC / 128; constexpr int NIT = MTL * NNT + MTC * (NNT - 8);
        for (int it = B0; it < NIT; it += G) { int mt, nt; if (it < MTL * NNT) { mt = it % MTL; nt = it / MTL; } else { int j = it - MTL * NNT; mt = MTL + j % MTC; nt = 8 + j / MTC; }
            const int n0 = nt * 128;
            GemmA a{(const bf16*)(p.ws + WS_HB), DM, nullptr, mt * 128, 128}; GemmB bb{p.in[I_cd_w_in], nullptr, CD_IN, n0, CD_IN, 0, DM};
            const int ct = n0 < 512 ? CT_ROPE_SCALE : n0 < 1024 ? CT_RAW : n0 < 1536 ? CT_ROPE : n0 < 2048 ? CT_VT : CT_RAW;
            EpiProj epi{&p, mt * 128, n0, CD_IN, ct, 1536, 128, 4}; gemm_tile(smem, a, bb, epi); } }
    GRID_SYNC();
    if (PH(12)) for (int it = B0; it < CONV_ITEMS; it += G) ssdconv_item(p, it);
    if (PH(13)) for (int it = B0; it < ATT1_N; it += G) att1_item(p, smem, it);
    GRID_SYNC();
    if (PH(14)) for (int it = B0; it < SSD1_ITEMS; it += G) ssd1_item(p, smem, it);
    GRID_SYNC();
    if (PH(15)) for (int it = B0; it < SSD2_ITEMS; it += G) ssd2_item(p, it);
    GRID_SYNC();
    if (PH(16)) for (int it = B0; it < SSD3_ITEMS; it += G) ssd3_item(p, smem, it);
    GRID_SYNC();
    if (PH(17)) for (int it = B0; it < (TL / 128) * (DM / 128); it += G) { const int mt = it % (TL / 128), nt = it / (TL / 128);
        GemmA a{(const bf16*)(p.ws + WS_CAT), LDC, nullptr, mt * 128, 128}; GemmB bb{p.in[I_cd_w_out], nullptr, DM, nt * 128, DM, 0, 1024};
        EpiOut epi{&p, mt * 128, nt * 128, 1}; gemm_tile(smem, a, bb, epi); }
    GRID_SYNC();
    if (PH(18)) for (int it = B0; it < (TL + 7) / 8; it += G) router_item(p, smem, it, 1, TL);
    GRID_SYNC();
    if (PH(19)) moe_g1_phase(p, smem, 1, TL);
    GRID_SYNC();
    if (PH(20)) moe_g2_phase(p, smem, 1, TL);
    GRID_SYNC();
    if (PH(21)) combine_phase(p, smem, 1, TL);
}

extern "C" void kernel_launch(void* const* d_in, const int* in_sizes, int n_in, void* d_out, int out_size, void* d_ws, size_t ws_size, hipStream_t stream) {
    if (n_in != N_IN || ws_size < WS_TOTAL) { fprintf(stderr, "kernel_launch: bad args n_in=%d ws=%zu need %zu\n", n_in, ws_size, (size_t)WS_TOTAL); return; }
    Params p{};
    for (int i = 0; i < N_IN; ++i) p.in[i] = (const float*)d_in[i];
    p.out = (float*)d_out; p.ws = (char*)d_ws;
    (void)hipMemsetAsync(d_ws, 0, CTL_BYTES, stream);
#ifdef HIP_EMU
    int grid = 8; if (getenv("EMU_GRID")) grid = atoi(getenv("EMU_GRID"));
    emu_launch(mega, dim3(grid), dim3(256), SMEM_BYTES, p);
#else
    static int grid = 0;
    if (!grid) { int dev = 0, cus = 0, per_cu = 0; hipGetDevice(&dev); hipDeviceGetAttribute(&cus, hipDeviceAttributeMultiprocessorCount, dev);
        hipOccupancyMaxActiveBlocksPerMultiprocessor(&per_cu, mega, 256, 0); if (per_cu > 2) per_cu = 2; if (per_cu < 1) per_cu = 1; grid = cus * per_cu; }
    void* args[] = {&p};
    hipError_t e = hipLaunchCooperativeKernel((void*)mega, dim3(grid), dim3(256), args, 0, stream);
    if (e != hipSuccess) fprintf(stderr, "cooperative launch failed: %s (grid %d)\n", hipGetErrorString(e), grid);
#endif
}

#ifdef HIP_EMU
extern "C" void emu_cmp(const char* name, const void* ptr, int rows, int cols, int ld, int is_bf16);
extern "C" void emu_debug_compare(void* d_ws) {
    char* ws = (char*)d_ws;
    emu_cmp("L1_mod", ws + WS_MOD + (size_t)NR * NMOD * DM * 4, NR, NMOD * DM, NMOD * DM, 0);
    emu_cmp("L1_h", ws + WS_HB, TL, DM, DM, 1);
    emu_cmp("L1_cat", ws + WS_CAT, TL, 1024, LDC, 1);
    emu_cmp("L1_x1", ws + WS_X, TL, DM, DM, 0);
}
#endif
```

```cpp
#ifndef HIP_EMU
#include <hip/hip_runtime.h>
#include <hip/hip_cooperative_groups.h>
#endif
#include <cstdio>
#include <cstdint>
#include <cmath>

#ifndef CFG_D
#define CFG_D 1024
#define CFG_B 8
#define CFG_S 2048
#define CFG_C 256
#define CFG_E 64
#define CFG_DE 256
#endif

#define DEV __device__ __forceinline__

constexpr int DM = CFG_D, NB = CFG_B, SEQ = CFG_S, CTX = CFG_C, NE = CFG_E, DE = CFG_DE;
constexpr int TL = NB * SEQ, TC = NB * CTX, TT = TL + TC, KVL = CTX + SEQ;
constexpr int GRIDW = 64;
constexpr int LRUW = 512, LRUB = 8;
constexpr int AB_IN = 1792, CD_IN = 3088;
constexpr int LDP = 3088;
constexpr int LDC = 1024;
constexpr int NMOD = 6, NR = NB + 1;
constexpr int PER = NE / 8;
constexpr int NCC = CTX / 128, NCL = SEQ / 128, NCH = NCC + NCL;
constexpr int LCH = 32;
constexpr int LNC = CTX / LCH, LNL = SEQ / LCH, LNT = LNC + LNL;
constexpr float EPS = 1e-6f;
static_assert(DM % 256 == 0 && SEQ % 128 == 0 && CTX % 128 == 0 && DE % 64 == 0 && NE % 8 == 0 && NE <= 64, "dims");

typedef unsigned short bf16;
typedef short bf16x8 __attribute__((ext_vector_type(8)));
typedef short bf16x4 __attribute__((ext_vector_type(4)));
typedef float f32x4 __attribute__((ext_vector_type(4)));
typedef float f32x2 __attribute__((ext_vector_type(2)));
typedef unsigned u32x4 __attribute__((ext_vector_type(4)));
typedef unsigned u32x2 __attribute__((ext_vector_type(2)));

constexpr size_t al256(size_t x) { return (x + 255) & ~(size_t)255; }
constexpr size_t WS_CTL = 0;
constexpr size_t CTL_BYTES = 65536;
constexpr int CW_CNT = 8192;
constexpr size_t WS_MOD = WS_CTL + CTL_BYTES;
constexpr size_t WS_ROPE = al256(WS_MOD + (size_t)2 * NR * NMOD * DM * 4);
constexpr size_t WS_SCAL = al256(WS_ROPE + (size_t)SEQ * 64 * 4);
constexpr size_t WS_WRT = al256(WS_SCAL + 256);
constexpr size_t WS_REF = al256(WS_WRT + (size_t)2 * 2 * NE * DM * 2);
constexpr size_t WS_LIST = al256(WS_REF + (size_t)TT * 8 * 4);
constexpr size_t WS_LISTW = al256(WS_LIST + (size_t)NE * TT * 4);
constexpr size_t WS_WPROJ = al256(WS_LISTW + (size_t)NE * TT * 4);
constexpr size_t WP_ABIN = 0, WP_ABOUT = WP_ABIN + (size_t)AB_IN * DM, WP_CDIN = WP_ABOUT + (size_t)DM * 1024, WP_CDOUT = WP_CDIN + (size_t)3200 * DM, WP_END = WP_CDOUT + (size_t)DM * 1024;
constexpr size_t WS_WDN = al256(WS_WPROJ + WP_END * 2);
constexpr size_t WS_X = al256(WS_WDN + (size_t)(NE + 1) * DM * DE * 2);
constexpr size_t WS_ACT = al256(WS_X + (size_t)TT * DM * 4);
constexpr size_t WS_BIG = al256(WS_ACT + (size_t)TT * 9 * DE * 2);
constexpr size_t WS_HB = WS_ACT;
constexpr size_t WS_Y = WS_BIG;
constexpr size_t WS_HA = WS_BIG;
constexpr size_t WS_PROJ = al256(WS_HA + (size_t)TT * DM * 2);
constexpr size_t WS_CAT = al256(WS_PROJ + (size_t)TT * LDP * 2);
constexpr size_t WS_VT = al256(WS_CAT + (size_t)TT * LDC * 2);
constexpr size_t WS_U = al256(WS_VT + (size_t)NB * 4 * 128 * KVL * 2);
constexpr size_t WS_AGG = WS_U;
constexpr size_t WS_DTV = al256(WS_U + (size_t)TT * 1024 * 2);
constexpr size_t WS_ST = al256(WS_DTV + (size_t)TT * 16 * 4);
constexpr size_t WS_DEC = al256(WS_ST + (size_t)NB * NCH * 2 * 8 * 8192 * 4);
constexpr size_t WS_MIXEND = al256(WS_DEC + (size_t)NB * NCH * 16 * 4);
constexpr size_t WS_YEND = al256(WS_Y + (size_t)TT * 9 * DM * 2);
constexpr size_t WS_TOTAL = WS_MIXEND > WS_YEND ? WS_MIXEND : WS_YEND;
constexpr size_t WGU_BYTES = (size_t)(NE + 1) * 2 * DE * DM * 2;
constexpr size_t WS_WGU = WS_PROJ;
static_assert(WS_WGU + WGU_BYTES <= WS_TOTAL, "WGU fits");
static_assert((size_t)NB * LNT * 4 * 512 * 4 <= (size_t)TT * 1024 * 2, "AGG fits in U");

constexpr int SMEM_BYTES = 71680;

#ifdef HIP_EMU
#define MFMA16(a, b, c) emu_mfma_16x16x32_bf16(a, b, c)
#define WAIT_VM0() do {} while (0)
DEV void glds16(const void* g, void* l) { emu_glds16(g, l); }
#else
#define MFMA16(a, b, c) __builtin_amdgcn_mfma_f32_16x16x32_bf16(a, b, c, 0, 0, 0)
#define WAIT_VM0() asm volatile("s_waitcnt vmcnt(0)" ::: "memory")
DEV void glds16(const void* g, void* l) {
    __builtin_amdgcn_global_load_lds((const __attribute__((address_space(1))) unsigned*)g, (__attribute__((address_space(3))) unsigned*)l, 16, 0, 0);
}
#endif

#ifdef HIP_EMU
DEV int tidx() { return (int)threadIdx.x; }
#else
DEV int tidx() { int t = threadIdx.x; asm volatile("" : "+v"(t)); return t; }
#endif
DEV unsigned f2bf(float f) { unsigned u = __builtin_bit_cast(unsigned, f); return (u + 0x7fffu + ((u >> 16) & 1u)) >> 16; }
DEV float bf2f(unsigned h) { return __builtin_bit_cast(float, h << 16); }
DEV unsigned pk2(float lo, float hi) { return f2bf(lo) | (f2bf(hi) << 16); }
DEV float bflo(unsigned u) { return __builtin_bit_cast(float, u << 16); }
DEV float bfhi(unsigned u) { return __builtin_bit_cast(float, u & 0xffff0000u); }
DEV float sigmoidf_(float x) { return 1.0f / (1.0f + __expf(-x)); }
DEV float siluf_(float x) { return x * sigmoidf_(x); }
DEV float softplusf_(float x) { return x > 20.f ? x : log1pf(__expf(x)); }
DEV float geluf_(float x) { float u = 0.7978845608028654f * (x + 0.044715f * x * x * x); float e = __expf(-2.0f * fabsf(u)); float t = (1.0f - e) / (1.0f + e); t = u < 0.f ? -t : t; return 0.5f * x * (1.0f + t); }
DEV float wave_sum(float v) {
#pragma unroll
    for (int m = 32; m >= 1; m >>= 1) v += __shfl_xor(v, m);
    return v;
}
DEV bf16x8 pack8(float a0, float a1, float a2, float a3, float a4, float a5, float a6, float a7) {
    u32x4 u; u.x = pk2(a0, a1); u.y = pk2(a2, a3); u.z = pk2(a4, a5); u.w = pk2(a6, a7); return __builtin_bit_cast(bf16x8, u);
}
DEV void st_bf16x4(bf16* p, float a, float b, float c, float d) { u32x2 u; u.x = pk2(a, b); u.y = pk2(c, d); *(u32x2*)p = u; }

enum { I_x, I_c, I_ctx, I_c_ctx, I_w_mod, I_b_mod, I_g_mix, I_g_ffn, I_g_final,
       I_ab_w_in, I_ab_w_out, I_ab_conv_w, I_ab_conv_b, I_ab_w_r, I_ab_b_r, I_ab_w_i, I_ab_b_i, I_ab_lam, I_ab_sink,
       I_cd_w_in, I_cd_w_out, I_cd_lam, I_cd_subln_g, I_cd_conv_w, I_cd_conv_b, I_cd_dt_bias, I_cd_a_log, I_cd_d_skip, I_cd_norm_g,
       I_w_router, I_b_router, I_w_e_gate, I_w_e_up, I_w_e_down, I_ws_gate, I_ws_up, I_ws_down, N_IN };

struct Params { const float* in[N_IN]; float* out; char* ws; };
#ifdef HIP_EMU
typedef const Params* KP;
#else
typedef const Params __attribute__((address_space(4))) * KP;
DEV KP kparams() { KP q = (KP)__builtin_amdgcn_kernarg_segment_ptr(); asm volatile("" : "+s"(q)); return q; }
#endif

DEV int mod_row(int t) { return t < TL ? t / SEQ : NB; }
DEV const float* modp(KP p, int l, int t, int which) { return (const float*)(p->ws + WS_MOD) + ((size_t)(l * NR + mod_row(t)) * NMOD + which) * DM; }

constexpr int MOD_CG = NMOD * DM / 64;
DEV void mod_item(KP p, char* smem, int it) {
    const int tid = tidx(), l = it / MOD_CG, cg = it % MOD_CG;
    float* S = (float*)smem;
    float* RED = S + NR * DM;
    __syncthreads();
    for (int i = tid; i < NR * DM; i += 256) { int r = i / DM, k = i % DM; float v = r < NB ? p->in[I_c][r * DM + k] : p->in[I_c_ctx][k]; S[i] = siluf_(v); }
    __syncthreads();
    const int col = cg * 64 + (tid & 63), ks = tid >> 6;
    const float* W = p->in[I_w_mod] + (size_t)l * DM * NMOD * DM + col;
    float acc[NR];
#pragma unroll
    for (int r = 0; r < NR; ++r) acc[r] = 0.f;
    for (int k = ks * (DM / 4); k < (ks + 1) * (DM / 4); ++k) {
        float w = W[(size_t)k * NMOD * DM];
#pragma unroll
        for (int r = 0; r < NR; ++r) acc[r] += S[r * DM + k] * w;
    }
#pragma unroll
    for (int r = 0; r < NR; ++r) RED[(ks * NR + r) * 64 + (tid & 63)] = acc[r];
    __syncthreads();
    for (int i = tid; i < NR * 64; i += 256) { int r = i / 64, c = i % 64;
        float v = RED[(0 * NR + r) * 64 + c] + RED[(1 * NR + r) * 64 + c] + RED[(2 * NR + r) * 64 + c] + RED[(3 * NR + r) * 64 + c];
        int cc = cg * 64 + c; ((float*)(p->ws + WS_MOD))[(size_t)(l * NR + r) * NMOD * DM + cc] = v + p->in[I_b_mod][l * NMOD * DM + cc]; }
}
DEV void rope_item(KP p, int it) {
    int i = it * 256 + tidx();
    if (i < SEQ * 32) { int s = i >> 5, j = i & 31; float pos = (float)(j < 16 ? s / GRIDW : s % GRIDW);
        float inv = powf(10000.0f, -(float)(j & 15) / 16.0f); float ang = pos * inv;
        ((float*)(p->ws + WS_ROPE))[i] = cosf(ang); ((float*)(p->ws + WS_ROPE))[SEQ * 32 + i] = sinf(ang); }
}
constexpr int WRT_ITEMS = 2 * (DM / 64);
DEV void wrt_item(KP p, int it) {
    const int tid = tidx(), l = it / (DM / 64), k0 = (it % (DM / 64)) * 64; bf16* WRT = (bf16*)(p->ws + WS_WRT) + (size_t)l * 2 * NE * DM;
    for (int i = tid; i < 64 * NE; i += 256) { int e = i >> 6, k = k0 + (i & 63); float w = p->in[I_w_router][((size_t)l * DM + k) * NE + e]; unsigned hi = f2bf(w); float lo = w - bf2f(hi);
        WRT[(size_t)e * DM + k] = (bf16)hi; WRT[(size_t)(NE + e) * DM + k] = (bf16)f2bf(lo); }
}
DEV void lam_item(KP p) {
    if (tidx() < 64) { const float* lv = p->in[I_cd_lam]; int i = tidx();
        float a = wave_sum(lv[i] * lv[64 + i]), b = wave_sum(lv[128 + i] * lv[192 + i]);
        if (i == 0) { float lam_init = 0.8f - 0.6f * expf(-0.3f); ((float*)(p->ws + WS_SCAL))[0] = expf(a) - expf(b) + lam_init; ((float*)(p->ws + WS_SCAL))[1] = lam_init; } }
}

constexpr int NV = DM / 256;
DEV void load_row(const float* row, int lane, f32x4 (&v)[NV]) {
#pragma unroll
    for (int i = 0; i < NV; ++i) v[i] = *(const f32x4*)(row + i * 256 + lane * 4);
}
DEV float row_rstd(const f32x4 (&v)[NV]) {
    float ss = 0.f;
#pragma unroll
    for (int i = 0; i < NV; ++i) ss += v[i][0] * v[i][0] + v[i][1] * v[i][1] + v[i][2] * v[i][2] + v[i][3] * v[i][3];
    ss = wave_sum(ss); return rsqrtf(ss * (1.0f / DM) + EPS);
}
DEV void norm_mod(const f32x4 (&v)[NV], float rstd, const float* g, const float* shift, const float* scale, int lane, f32x4 (&h)[NV]) {
#pragma unroll
    for (int i = 0; i < NV; ++i) { int k = i * 256 + lane * 4; f32x4 gg = *(const f32x4*)(g + k), sh = *(const f32x4*)(shift + k), sc = *(const f32x4*)(scale + k);
#pragma unroll
        for (int j = 0; j < 4; ++j) h[i][j] = v[i][j] * rstd * gg[j] * (1.0f + sc[j]) + sh[j]; }
}
DEV void store_row_bf16(bf16* row, int lane, const f32x4 (&h)[NV]) {
#pragma unroll
    for (int i = 0; i < NV; ++i) st_bf16x4(row + i * 256 + lane * 4, h[i][0], h[i][1], h[i][2], h[i][3]);
}
DEV void norm0_item(KP p, int it) {
    const int lane = tidx() & 63, t = it * 4 + (tidx() >> 6);
    const float* row = t < TL ? p->in[I_x] + (size_t)t * DM : p->in[I_ctx] + (size_t)(t - TL) * DM;
    f32x4 v[NV], h[NV]; load_row(row, lane, v); float rstd = row_rstd(v);
    norm_mod(v, rstd, p->in[I_g_mix], modp(p, 0, t, 0), modp(p, 0, t, 1), lane, h);
    store_row_bf16((bf16*)(p->ws + WS_HA) + (size_t)t * DM, lane, h);
}

DEV void convT_tile(char* smem, const float* srcA, int ca, const float* srcB, int cb, int lds, int ncol, int k0, bf16* dst, int ldd) {
    float* T = (float*)smem;
    const int tid = tidx();
    __syncthreads();
    { const int half = tid >> 7, r = (tid >> 3) & 15, c4 = (tid & 7) * 4; const float* src = half ? srcB : srcA; const int c = (half ? cb : ca) + c4;
#pragma unroll
      for (int ps = 0; ps < 4; ++ps) { const int k = r + ps * 16; f32x4 v = (f32x4){0.f, 0.f, 0.f, 0.f};
          if (c + 3 < ncol) v = *(const f32x4*)(src + (size_t)(k0 + k) * lds + c);
          else { for (int j = 0; j < 4; ++j) if (c + j < ncol) v[j] = src[(size_t)(k0 + k) * lds + c + j]; }
          float* tp = T + k * 65 + half * 32 + c4; tp[0] = v[0]; tp[1] = v[1]; tp[2] = v[2]; tp[3] = v[3]; } }
    __syncthreads();
    { const int n = tid >> 2, kq = (tid & 3) * 16; float v[16];
#pragma unroll
      for (int i = 0; i < 16; ++i) v[i] = T[(kq + i) * 65 + n];
      bf16* d = dst + (size_t)n * ldd + k0 + kq;
      *(bf16x8*)d = pack8(v[0], v[1], v[2], v[3], v[4], v[5], v[6], v[7]); *(bf16x8*)(d + 8) = pack8(v[8], v[9], v[10], v[11], v[12], v[13], v[14], v[15]); }
}
DEV void conv_plain_item(char* smem, const float* src, int K, int N, bf16* dst, int it) {
    const int kt = it % (K / 64), nt = it / (K / 64);
    convT_tile(smem, src, nt * 64, src, nt * 64 + 32, N, N, kt * 64, dst + (size_t)nt * 64 * K, K);
}
constexpr int CVP_ABIN = (AB_IN / 64) * (DM / 64), CVP_ABOUT = (DM / 64) * (1024 / 64), CVP_CDIN = (3200 / 64) * (DM / 64), CVP_CDOUT = (DM / 64) * (1024 / 64);
constexpr int CVP_ITEMS = CVP_ABIN + CVP_ABOUT + CVP_CDIN + CVP_CDOUT;
DEV void conv_proj_item(KP p, char* smem, int it) {
    bf16* WP = (bf16*)(p->ws + WS_WPROJ);
    if (it < CVP_ABIN) { conv_plain_item(smem, p->in[I_ab_w_in], DM, AB_IN, WP + WP_ABIN, it); return; } it -= CVP_ABIN;
    if (it < CVP_ABOUT) { conv_plain_item(smem, p->in[I_ab_w_out], 1024, DM, WP + WP_ABOUT, it); return; } it -= CVP_ABOUT;
    if (it < CVP_CDIN) { conv_plain_item(smem, p->in[I_cd_w_in], DM, CD_IN, WP + WP_CDIN, it); return; } it -= CVP_CDIN;
    conv_plain_item(smem, p->in[I_cd_w_out], 1024, DM, WP + WP_CDOUT, it);
}
constexpr int CVM_GU = (NE + 1) * (DE / 32) * (DM / 64), CVM_DN = (NE + 1) * (DM / 64) * (DE / 64), CVM_ITEMS = CVM_GU + CVM_DN;
DEV void conv_moe_item(KP p, char* smem, int l, int it) {
    if (it < CVM_GU) { const int kt = it % (DM / 64), j = (it / (DM / 64)) % (DE / 32), e = it / ((DM / 64) * (DE / 32));
        const float* wg = e < NE ? p->in[I_w_e_gate] + ((size_t)l * NE + e) * DM * DE : p->in[I_ws_gate] + (size_t)l * DM * DE;
        const float* wu = e < NE ? p->in[I_w_e_up] + ((size_t)l * NE + e) * DM * DE : p->in[I_ws_up] + (size_t)l * DM * DE;
        convT_tile(smem, wg, j * 32, wu, j * 32, DE, DE, kt * 64, (bf16*)(p->ws + WS_WGU) + ((size_t)e * 2 * DE + j * 64) * DM, DM);
    } else { it -= CVM_GU; const int kt = it % (DE / 64), nt = (it / (DE / 64)) % (DM / 64), e = it / ((DE / 64) * (DM / 64));
        const float* wd = e < NE ? p->in[I_w_e_down] + ((size_t)l * NE + e) * DE * DM : p->in[I_ws_down] + (size_t)l * DE * DM;
        convT_tile(smem, wd, nt * 64, wd, nt * 64 + 32, DM, DM, kt * 64, (bf16*)(p->ws + WS_WDN) + ((size_t)e * DM + nt * 64) * DE, DE); }
}

struct GemmA { const bf16* A; int lda; const int* list; int row0; int nvalid; };
struct GemmB { const bf16* Bt; int ldb; };
template <class Epi> DEV void gemm_tile(char* smem, const GemmA& a, const GemmB& b, int K, Epi& epi) {
    const int tid = tidx(), lane = tid & 63, wid = tid >> 6, wr = wid >> 1, wc = wid & 1, fr = lane & 15, fq = lane >> 4;
    const int csrc = ((tid & 7) ^ ((tid >> 4) & 7)) * 8;
    const bf16* pA[4]; const bf16* pB = b.Bt + (size_t)(tid >> 3) * b.ldb + csrc;
#pragma unroll
    for (int i = 0; i < 4; ++i) { int r = (tid >> 3) + i * 32; int rr = r < a.nvalid ? r : a.nvalid - 1; int grow = a.list ? a.list[rr] : a.row0 + rr; pA[i] = a.A + (size_t)grow * a.lda + csrc; }
    const int sw = (fr >> 1) & 7; const int c0 = ((fq ^ sw) * 16), c1 = (((4 + fq) ^ sw) * 16);
    const int offA = (wr * 64 + fr) * 128, offB = 16384 + (wc * 64 + fr) * 128;
    f32x4 acc[4][4];
#pragma unroll
    for (int m = 0; m < 4; ++m)
#pragma unroll
        for (int n = 0; n < 4; ++n) acc[m][n] = (f32x4){0.f, 0.f, 0.f, 0.f};
    const int nk = K / 64;
    __syncthreads();
#pragma unroll
    for (int i = 0; i < 4; ++i) { glds16(pA[i], smem + tid * 16 + i * 4096); glds16(pB + (size_t)i * 32 * b.ldb, smem + 16384 + tid * 16 + i * 4096); }
    for (int kt = 0; kt < nk; ++kt) {
        WAIT_VM0(); __syncthreads();
        char* cur = smem + (kt & 1) * 32768;
        if (kt + 1 < nk) { char* nxt = smem + ((kt + 1) & 1) * 32768;
#pragma unroll
            for (int i = 0; i < 4; ++i) { glds16(pA[i] + (kt + 1) * 64, nxt + tid * 16 + i * 4096); glds16(pB + (size_t)i * 32 * b.ldb + (kt + 1) * 64, nxt + 16384 + tid * 16 + i * 4096); } }
#pragma unroll
        for (int ks = 0; ks < 2; ++ks) { const int cc = ks ? c1 : c0;
            bf16x8 At[4], Bt[4];
#pragma unroll
            for (int m = 0; m < 4; ++m) At[m] = *(const bf16x8*)(cur + offA + m * 2048 + cc);
#pragma unroll
            for (int n = 0; n < 4; ++n) Bt[n] = *(const bf16x8*)(cur + offB + n * 2048 + cc);
#pragma unroll
            for (int m = 0; m < 4; ++m)
#pragma unroll
                for (int n = 0; n < 4; ++n) acc[m][n] = MFMA16(Bt[n], At[m], acc[m][n]); }
    }
    epi(acc, wr * 64 + fr, wc * 64 + fq * 4);
}
DEV int vblock() { const int G = gridDim.x, b = blockIdx.x; return (G % 8 == 0) ? (b % 8) * (G / 8) + b / 8 : b; }

enum { CT_RAW = 0, CT_GELU = 1, CT_ROPE_SCALE = 2, CT_ROPE = 3, CT_VT = 4 };
struct EpiProj {
    KP p; int row0; int n0; int N; int ctype; int vcol0; int vdim; int vheads;
    DEV void operator()(f32x4 (&acc)[4][4], int rl0, int cl0) const {
        bf16* PROJ = (bf16*)(p->ws + WS_PROJ);
        const float* RC = (const float*)(p->ws + WS_ROPE); const float* RS = RC + SEQ * 32;
#pragma unroll
        for (int m = 0; m < 4; ++m) {
            const int t = row0 + rl0 + m * 16; const bool lat = t < TL; const int s = lat ? t % SEQ : 0;
            if (ctype == CT_ROPE_SCALE || ctype == CT_ROPE) {
                const float sc = ctype == CT_ROPE_SCALE ? 0.125f : 1.0f;
#pragma unroll
                for (int n = 0; n < 2; ++n) {
                    f32x4 x1 = acc[m][n], x2 = acc[m][n + 2], o1, o2;
                    if (lat) { const int i0 = n * 16 + (cl0 & 15); f32x4 c = *(const f32x4*)(RC + s * 32 + i0), sn = *(const f32x4*)(RS + s * 32 + i0);
#pragma unroll
                        for (int j = 0; j < 4; ++j) { o1[j] = (x1[j] * c[j] - x2[j] * sn[j]) * sc; o2[j] = (x1[j] * sn[j] + x2[j] * c[j]) * sc; } }
                    else { o1 = x1 * sc; o2 = x2 * sc; }
                    acc[m][n] = o1; acc[m][n + 2] = o2;
                }
            }
#pragma unroll
            for (int n = 0; n < 4; ++n) {
                const int cl = cl0 + n * 16, c = n0 + cl; f32x4 v = acc[m][n];
                if (ctype == CT_GELU) {
#pragma unroll
                    for (int j = 0; j < 4; ++j) v[j] = geluf_(v[j]); }
                if (ctype == CT_VT) {
                    const int b = lat ? t / SEQ : (t - TL) / CTX; const int kk = lat ? CTX + s : (t - TL) % CTX;
                    bf16* VT = (bf16*)(p->ws + WS_VT);
#pragma unroll
                    for (int j = 0; j < 4; ++j) { int cv = c - vcol0 + j; int hh = cv / vdim, d = cv % vdim; VT[((size_t)(b * vheads + hh) * vdim + d) * KVL + kk] = (bf16)f2bf(v[j]); }
                } else if (c < N) st_bf16x4(PROJ + (size_t)t * LDP + c, v[0], v[1], v[2], v[3]);
            }
        }
    }
};
struct EpiOut {
    KP p; int row0; int n0; int layer;
    DEV void operator()(f32x4 (&acc)[4][4], int rl0, int cl0) const {
        float* X = (float*)(p->ws + WS_X);
#pragma unroll
        for (int m = 0; m < 4; ++m) { const int t = row0 + rl0 + m * 16;
            const float* xin = layer == 0 ? (t < TL ? p->in[I_x] + (size_t)t * DM : p->in[I_ctx] + (size_t)(t - TL) * DM) : X + (size_t)t * DM;
            const float* g1 = modp(p, layer, t, 2);
#pragma unroll
            for (int n = 0; n < 4; ++n) { const int c = n0 + cl0 + n * 16; f32x4 xi = *(const f32x4*)(xin + c), g = *(const f32x4*)(g1 + c);
                *(f32x4*)(X + (size_t)t * DM + c) = xi + g * acc[m][n]; } }
    }
};
struct EpiG1 {
    bf16* ACT; int slot0; int nvalid; int hb;
    DEV void operator()(f32x4 (&acc)[4][4], int rl0, int cl0) const {
        const int wc = cl0 >> 6, fq4 = cl0 & 63;
#pragma unroll
        for (int m = 0; m < 4; ++m) { const int rl = rl0 + m * 16; if (rl < nvalid) {
#pragma unroll
            for (int n = 0; n < 2; ++n) { f32x4 g = acc[m][n], u = acc[m][n + 2];
                st_bf16x4(ACT + (size_t)(slot0 + rl) * DE + hb + wc * 32 + n * 16 + fq4, siluf_(g[0]) * u[0], siluf_(g[1]) * u[1], siluf_(g[2]) * u[2], siluf_(g[3]) * u[3]); } } }
    }
};
struct EpiG2 {
    bf16* Y; int slot0; int nvalid; int n0; const float* w;
    DEV void operator()(f32x4 (&acc)[4][4], int rl0, int cl0) const {
#pragma unroll
        for (int m = 0; m < 4; ++m) { const int rl = rl0 + m * 16; if (rl < nvalid) { const float ww = w ? w[rl] : 1.0f;
#pragma unroll
            for (int n = 0; n < 4; ++n) { f32x4 v = acc[m][n] * ww; st_bf16x4(Y + (size_t)(slot0 + rl) * DM + n0 + cl0 + n * 16, v[0], v[1], v[2], v[3]); } } }
    }
};

constexpr int KSTR = 144, VSTR = 144;
template <int DV, bool WINDOW>
DEV void flash_block(char* smem, const bf16* Qp, int ldq, const bf16* Kbase, int ldk, int ctx_row0, int lat_row0, const bf16* VTp,
                     int r0a, int r1a, int r0b, int r1b, int q0, float m_init, float l_init, f32x4 (&o)[DV / 16][2]) {
    char* SK = smem; char* SV = smem + 64 * KSTR;
    const int tid = tidx(), lane = tid & 63, w = tid >> 6, fr = lane & 15, fq = lane >> 4;
    bf16x8 qfr[2][2];
#pragma unroll
    for (int qf = 0; qf < 2; ++qf)
#pragma unroll
        for (int ks = 0; ks < 2; ++ks) qfr[qf][ks] = *(const bf16x8*)(Qp + (size_t)(w * 32 + qf * 16 + fr) * ldq + ks * 32 + fq * 8);
    float mrow[2] = {m_init, m_init}, lrow[2] = {l_init, l_init};
#pragma unroll
    for (int df = 0; df < DV / 16; ++df) { o[df][0] = (f32x4){0.f, 0.f, 0.f, 0.f}; o[df][1] = (f32x4){0.f, 0.f, 0.f, 0.f}; }
    for (int rg = 0; rg < 2; ++rg) {
        const int k0 = rg ? r0b : r0a, k1 = rg ? r1b : r1a;
        for (int kk0 = k0; kk0 < k1; kk0 += 64) {
            __syncthreads();
#pragma unroll
            for (int i = 0; i < 2; ++i) { int c = tid + i * 256, key = c >> 3, part = c & 7; int kk = kk0 + key; int row = kk < CTX ? ctx_row0 + kk : lat_row0 + kk - CTX;
                *(u32x4*)(SK + key * KSTR + part * 16) = *(const u32x4*)(Kbase + (size_t)row * ldk + part * 8); }
#pragma unroll
            for (int i = 0; i < DV / 32; ++i) { int c = tid + i * 256, d = c >> 3, part = c & 7;
                *(u32x4*)(SV + d * VSTR + part * 16) = *(const u32x4*)(VTp + (size_t)d * KVL + kk0 + part * 8); }
            __syncthreads();
            f32x4 s[4][2];
#pragma unroll
            for (int kf = 0; kf < 4; ++kf) { s[kf][0] = (f32x4){0.f, 0.f, 0.f, 0.f}; s[kf][1] = (f32x4){0.f, 0.f, 0.f, 0.f};
#pragma unroll
                for (int ks = 0; ks < 2; ++ks) { bf16x8 kfrag = *(const bf16x8*)(SK + (kf * 16 + fr) * KSTR + ks * 64 + fq * 16);
                    s[kf][0] = MFMA16(kfrag, qfr[0][ks], s[kf][0]); s[kf][1] = MFMA16(kfrag, qfr[1][ks], s[kf][1]); } }
            if (WINDOW && kk0 >= CTX) {
#pragma unroll
                for (int kf = 0; kf < 4; ++kf)
#pragma unroll
                    for (int qf = 0; qf < 2; ++qf)
#pragma unroll
                        for (int j = 0; j < 4; ++j) { int kpos = kk0 - CTX + kf * 16 + fq * 4 + j, qpos = q0 + w * 32 + qf * 16 + fr; int dd = qpos - kpos; if (dd > 128 || dd < -128) s[kf][qf][j] = -1e30f; }
            }
            bf16x8 pfr[2][2];
#pragma unroll
            for (int qf = 0; qf < 2; ++qf) {
                float tm = -1e30f;
#pragma unroll
                for (int kf = 0; kf < 4; ++kf)
#pragma unroll
                    for (int j = 0; j < 4; ++j) tm = fmaxf(tm, s[kf][qf][j]);
                tm = fmaxf(tm, __shfl_xor(tm, 16)); tm = fmaxf(tm, __shfl_xor(tm, 32));
                const float mn = fmaxf(mrow[qf], tm), alpha = __expf(mrow[qf] - mn); mrow[qf] = mn;
                float rs = 0.f;
#pragma unroll
                for (int kf = 0; kf < 4; ++kf)
#pragma unroll
                    for (int j = 0; j < 4; ++j) { float e = __expf(s[kf][qf][j] - mn); s[kf][qf][j] = e; rs += e; }
                rs += __shfl_xor(rs, 16); rs += __shfl_xor(rs, 32);
                lrow[qf] = lrow[qf] * alpha + rs;
#pragma unroll
                for (int df = 0; df < DV / 16; ++df) o[df][qf] = o[df][qf] * alpha;
#pragma unroll
                for (int k2 = 0; k2 < 2; ++k2) pfr[qf][k2] = pack8(s[2 * k2][qf][0], s[2 * k2][qf][1], s[2 * k2][qf][2], s[2 * k2][qf][3], s[2 * k2 + 1][qf][0], s[2 * k2 + 1][qf][1], s[2 * k2 + 1][qf][2], s[2 * k2 + 1][qf][3]);
            }
#pragma unroll
            for (int df = 0; df < DV / 16; ++df)
#pragma unroll
                for (int k2 = 0; k2 < 2; ++k2) {
                    u32x2 lo = *(const u32x2*)(SV + (df * 16 + fr) * VSTR + (k2 * 32 + fq * 4) * 2), hi = *(const u32x2*)(SV + (df * 16 + fr) * VSTR + (k2 * 32 + 16 + fq * 4) * 2);
                    u32x4 vv; vv.x = lo.x; vv.y = lo.y; vv.z = hi.x; vv.w = hi.y; bf16x8 vfrag = __builtin_bit_cast(bf16x8, vv);
                    o[df][0] = MFMA16(vfrag, pfr[0][k2], o[df][0]); o[df][1] = MFMA16(vfrag, pfr[1][k2], o[df][1]);
                }
        }
    }
#pragma unroll
    for (int qf = 0; qf < 2; ++qf) { const float inv = 1.0f / lrow[qf];
#pragma unroll
        for (int df = 0; df < DV / 16; ++df) o[df][qf] = o[df][qf] * inv; }
}

constexpr int ATT0_LAT = NB * NCL * 8, ATT0_CTX = NB * NCC * 8;
DEV void att0_item(KP p, char* smem, int it) {
    const bf16* PROJ = (const bf16*)(p->ws + WS_PROJ); bf16* CAT = (bf16*)(p->ws + WS_CAT);
    const bool isctx = it >= ATT0_LAT; if (isctx) it -= ATT0_LAT;
    const int nqb = isctx ? NCC : NCL; const int h = it % 8, qb = (it / 8) % nqb, b = it / (8 * nqb);
    const int qrow0 = isctx ? TL + b * CTX + qb * 128 : b * SEQ + qb * 128;
    const int lo = qb * 128 - 128 < 0 ? 0 : qb * 128 - 128, hi = qb * 128 + 256 > SEQ ? SEQ : qb * 128 + 256;
    f32x4 o[4][2];
    const bf16* Qp = PROJ + (size_t)qrow0 * LDP + 512 + h * 64; const bf16* Kb = PROJ + 1536 + (h / 4) * 64;
    const bf16* VTp = (const bf16*)(p->ws + WS_VT) + (size_t)(b * 2 + h / 4) * 64 * KVL; const float sink = p->in[I_ab_sink][h];
    if (isctx) flash_block<64, false>(smem, Qp, LDP, Kb, LDP, TL + b * CTX, b * SEQ, VTp, 0, CTX, 0, 0, 0, sink, 1.0f, o);
    else flash_block<64, true>(smem, Qp, LDP, Kb, LDP, TL + b * CTX, b * SEQ, VTp, 0, CTX, CTX + lo, CTX + hi, qb * 128, sink, 1.0f, o);
    const int lane = tidx() & 63, w = tidx() >> 6, fr = lane & 15, fq = lane >> 4;
#pragma unroll
    for (int qf = 0; qf < 2; ++qf)
#pragma unroll
        for (int df = 0; df < 4; ++df) st_bf16x4(CAT + (size_t)(qrow0 + w * 32 + qf * 16 + fr) * LDC + 512 + h * 64 + df * 16 + fq * 4, o[df][qf][0], o[df][qf][1], o[df][qf][2], o[df][qf][3]);
}
constexpr int ATT1_N = NB * NCL * 4;
DEV void att1_item(KP p, char* smem, int it) {
    const bf16* PROJ = (const bf16*)(p->ws + WS_PROJ); bf16* CAT = (bf16*)(p->ws + WS_CAT);
    const int h = it % 4, qb = (it / 4) % NCL, b = it / (4 * NCL); const int qrow0 = b * SEQ + qb * 128;
    const bf16* VTp = (const bf16*)(p->ws + WS_VT) + (size_t)(b * 4 + h) * 128 * KVL;
    f32x4 o0[8][2], o1[8][2];
    flash_block<128, false>(smem, PROJ + (size_t)qrow0 * LDP + h * 128, LDP, PROJ + 1024 + h * 128, LDP, TL + b * CTX, b * SEQ, VTp, 0, KVL, 0, 0, 0, -1e30f, 0.f, o0);
    u32x2* stash = (u32x2*)(smem + 27648) + tidx();
#pragma unroll
    for (int df = 0; df < 8; ++df)
#pragma unroll
        for (int qf = 0; qf < 2; ++qf) { u32x2 pk; pk.x = pk2(o0[df][qf][0], o0[df][qf][1]); pk.y = pk2(o0[df][qf][2], o0[df][qf][3]); stash[(df * 2 + qf) * 256] = pk; }
    flash_block<128, false>(smem, PROJ + (size_t)qrow0 * LDP + h * 128 + 64, LDP, PROJ + 1024 + h * 128 + 64, LDP, TL + b * CTX, b * SEQ, VTp, 0, KVL, 0, 0, 0, -1e30f, 0.f, o1);
    const float lam = ((const float*)(p->ws + WS_SCAL))[0], lam_init = ((const float*)(p->ws + WS_SCAL))[1];
    const int lane = tidx() & 63, w = tidx() >> 6, fr = lane & 15, fq = lane >> 4;
    const float* sg = p->in[I_cd_subln_g];
#pragma unroll
    for (int qf = 0; qf < 2; ++qf) {
        float ss = 0.f;
#pragma unroll
        for (int df = 0; df < 8; ++df) { u32x2 pk = stash[(df * 2 + qf) * 256]; o0[df][qf] = (f32x4){bflo(pk.x), bfhi(pk.x), bflo(pk.y), bfhi(pk.y)} - o1[df][qf] * lam;
#pragma unroll
            for (int j = 0; j < 4; ++j) ss += o0[df][qf][j] * o0[df][qf][j]; }
        ss += __shfl_xor(ss, 16); ss += __shfl_xor(ss, 32);
        const float sc = rsqrtf(ss * (1.0f / 128.0f) + EPS) * (1.0f - lam_init);
#pragma unroll
        for (int df = 0; df < 8; ++df) { f32x4 g = *(const f32x4*)(sg + df * 16 + fq * 4); f32x4 v = o0[df][qf] * sc * g;
            st_bf16x4(CAT + (size_t)(qrow0 + w * 32 + qf * 16 + fr) * LDC + h * 128 + df * 16 + fq * 4, v[0], v[1], v[2], v[3]); }
    }
}

constexpr int LRU_ITEMS = NB * LNT * LRUB;
DEV void lru_item(KP p, char* smem, int it, int pass) {
    const bf16* PROJ = (const bf16*)(p->ws + WS_PROJ); bf16* CAT = (bf16*)(p->ws + WS_CAT); float* AGG = (float*)(p->ws + WS_AGG);
    const int tid = tidx(), lane = tid & 63, w = tid >> 6, fr = lane & 15, fq = lane >> 4;
    const int blk = it % LRUB, ck = (it / LRUB) % LNT, b = it / (LRUB * LNT);
    const bool isctx = ck < LNC; const int cs = isctx ? ck : ck - LNC;
    const int seglen = isctx ? CTX : SEQ; const int segrow0 = isctx ? TL + b * CTX : b * SEQ; const int t0 = cs * LCH;
    bf16* XA = (bf16*)smem;
    float* U = (float*)(smem + 4608);
    bf16* WT = (bf16*)(smem + 4608 + 8192);
    float* A_ = (float*)(smem + 4608 + 8192 + 18432);
    float* BX = A_ + 2 * LCH * 64;
    __syncthreads();
    for (int i = tid; i < (LCH + 3) * 8; i += 256) { int r = i >> 3, part = i & 7; int t = t0 - 1 + r; u32x4 v = (u32x4){0u, 0u, 0u, 0u};
        if (t >= 0 && t < seglen) v = *(const u32x4*)(PROJ + (size_t)(segrow0 + t) * LDP + 1024 + blk * 64 + part * 8);
        *(u32x4*)(XA + r * 64 + part * 8) = v; }
    __syncthreads();
    { const float* cw = p->in[I_ab_conv_w]; const float* cb = p->in[I_ab_conv_b];
      for (int i = tid; i < LCH * 64; i += 256) { int r = i >> 6, ch = i & 63, gc = blk * 64 + ch; float a = cb[gc];
#pragma unroll
          for (int j = 0; j < 4; ++j) a += cw[j * LRUW + gc] * bf2f(XA[(r + j) * 64 + ch]);
          U[i] = a; } }
    for (int d = 0; d < 2; ++d) {
        __syncthreads();
        for (int i = tid; i < 2 * 64 * 16; i += 256) { int g = i >> 10, c = (i >> 4) & 63, n4 = (i & 15) * 4;
            const float* W = (g ? p->in[I_ab_w_i] : p->in[I_ab_w_r]) + ((size_t)(d * LRUB + blk) * 64 + c) * 64 + n4; f32x4 v = *(const f32x4*)W;
#pragma unroll
            for (int j = 0; j < 4; ++j) WT[(g * 64 + n4 + j) * 72 + c] = (bf16)f2bf(v[j]); }
        __syncthreads();
        f32x4 ar[2], ai[2];
#pragma unroll
        for (int tf = 0; tf < 2; ++tf) { ar[tf] = (f32x4){0.f, 0.f, 0.f, 0.f}; ai[tf] = (f32x4){0.f, 0.f, 0.f, 0.f}; }
#pragma unroll
        for (int ks = 0; ks < 2; ++ks) {
            bf16x8 wr_ = *(const bf16x8*)(WT + (0 * 64 + w * 16 + fr) * 72 + ks * 32 + fq * 8), wi_ = *(const bf16x8*)(WT + (1 * 64 + w * 16 + fr) * 72 + ks * 32 + fq * 8);
#pragma unroll
            for (int tf = 0; tf < 2; ++tf) { const float* up = U + (tf * 16 + fr) * 64 + ks * 32 + fq * 8; f32x4 u0 = *(const f32x4*)up, u1 = *(const f32x4*)(up + 4);
                bf16x8 uf = pack8(u0[0], u0[1], u0[2], u0[3], u1[0], u1[1], u1[2], u1[3]);
                ar[tf] = MFMA16(wr_, uf, ar[tf]); ai[tf] = MFMA16(wi_, uf, ai[tf]); }
        }
#pragma unroll
        for (int tf = 0; tf < 2; ++tf)
#pragma unroll
            for (int j = 0; j < 4; ++j) { const int tok = tf * 16 + fr, ch = w * 16 + fq * 4 + j, gc = blk * 64 + ch;
                float r = sigmoidf_(ar[tf][j] + p->in[I_ab_b_r][d * LRUW + gc]), ig = sigmoidf_(ai[tf][j] + p->in[I_ab_b_i][d * LRUW + gc]);
                float sp = softplusf_(-p->in[I_ab_lam][d * LRUW + gc]); float la = -8.0f * r * sp; float a = __expf(la);
                float u = U[tok * 64 + ch]; float bx = sqrtf(fmaxf(1.0f - a * a, 0.f)) * ig * u;
                A_[(d * LCH + tok) * 64 + ch] = a; BX[(d * LCH + tok) * 64 + ch] = bx; }
    }
    __syncthreads();
    if (tid < 128) { const int d = tid >> 6, ch = tid & 63, gc = blk * 64 + ch;
        float h = 0.f;
        if (pass == 2) {
            if (d == 0) { for (int c2 = 0; c2 < ck; ++c2) { const float* ag = AGG + ((size_t)(b * LNT + c2) * 2 + 0) * 1024; h = ag[gc] * h + ag[512 + gc]; } }
            else { if (isctx) { for (int c2 = LNC - 1; c2 > ck; --c2) { const float* ag = AGG + ((size_t)(b * LNT + c2) * 2 + 1) * 1024; h = ag[gc] * h + ag[512 + gc]; } }
                   else { for (int c2 = LNC - 1; c2 >= 0; --c2) { const float* ag = AGG + ((size_t)(b * LNT + c2) * 2 + 1) * 1024; h = ag[gc] * h + ag[512 + gc]; }
                          for (int c2 = LNT - 1; c2 > ck; --c2) { const float* ag = AGG + ((size_t)(b * LNT + c2) * 2 + 1) * 1024; h = ag[gc] * h + ag[512 + gc]; } } }
        }
        float ap = 1.f;
        for (int i = 0; i < LCH; ++i) { const int tok = d ? LCH - 1 - i : i; float a = A_[(d * LCH + tok) * 64 + ch], bx = BX[(d * LCH + tok) * 64 + ch]; h = a * h + bx; ap *= a; BX[(d * LCH + tok) * 64 + ch] = h; }
        if (pass == 1) { float* ag = AGG + ((size_t)(b * LNT + ck) * 2 + d) * 1024; ag[gc] = ap; ag[512 + gc] = h; }
    }
    if (pass == 2) {
        __syncthreads();
        for (int i = tid; i < LCH * 16; i += 256) { int r = i >> 4, c4 = (i & 15) * 4; const size_t row = (size_t)(segrow0 + t0 + r);
            u32x2 gg = *(const u32x2*)(PROJ + row * LDP + blk * 64 + c4);
            const float* h0 = BX + (0 * LCH + r) * 64 + c4; const float* h1 = BX + (1 * LCH + r) * 64 + c4;
            st_bf16x4(CAT + row * LDC + blk * 64 + c4, (h0[0] + h1[0]) * bflo(gg.x), (h0[1] + h1[1]) * bfhi(gg.x), (h0[2] + h1[2]) * bflo(gg.y), (h0[3] + h1[3]) * bfhi(gg.y)); }
    }
}

constexpr int HSTR = DM + 8;
DEV void router_item(KP p, char* smem, int it, int l, int ntok) {
    const int tid = tidx(), lane = tid & 63, w = tid >> 6, fr = lane & 15, fq = lane >> 4;
    bf16* HH = (bf16*)smem; bf16* HL = HH + 16 * HSTR; float* LG = (float*)(HL + 16 * HSTR);
    const float* X = (const float*)(p->ws + WS_X); bf16* H = (bf16*)(p->ws + WS_HA);
    unsigned* CNT = (unsigned*)(p->ws + WS_CTL) + CW_CNT + l * (NE + 1);
    const int t0 = it * 16;
    __syncthreads();
#pragma unroll 1
    for (int u = 0; u < 4; ++u) { const int tl = w * 4 + u, t = t0 + tl;
        f32x4 v[NV], h[NV];
        if (t < ntok) { load_row(X + (size_t)t * DM, lane, v); float rstd = row_rstd(v);
            norm_mod(v, rstd, p->in[I_g_ffn] + l * DM, modp(p, l, t, 3), modp(p, l, t, 4), lane, h);
            store_row_bf16(H + (size_t)t * DM, lane, h); }
        else {
#pragma unroll
            for (int i = 0; i < NV; ++i) h[i] = (f32x4){0.f, 0.f, 0.f, 0.f}; }
#pragma unroll
        for (int i = 0; i < NV; ++i) { unsigned h0 = f2bf(h[i][0]), h1 = f2bf(h[i][1]), h2 = f2bf(h[i][2]), h3 = f2bf(h[i][3]);
            u32x2 hi; hi.x = h0 | (h1 << 16); hi.y = h2 | (h3 << 16); *(u32x2*)(HH + tl * HSTR + i * 256 + lane * 4) = hi;
            st_bf16x4(HL + tl * HSTR + i * 256 + lane * 4, h[i][0] - bf2f(h0), h[i][1] - bf2f(h1), h[i][2] - bf2f(h2), h[i][3] - bf2f(h3)); } }
    __syncthreads();
    if (w * 16 < NE) {
        const bf16* Whi = (const bf16*)(p->ws + WS_WRT) + (size_t)l * 2 * NE * DM + (size_t)(w * 16 + fr) * DM + fq * 8; const bf16* Wlo = Whi + (size_t)NE * DM;
        f32x4 a0 = (f32x4){0.f, 0.f, 0.f, 0.f}, a1 = a0, a2 = a0;
#pragma unroll 4
        for (int ks = 0; ks < DM / 32; ++ks) { bf16x8 wh = *(const bf16x8*)(Whi + ks * 32), wl = *(const bf16x8*)(Wlo + ks * 32);
            bf16x8 hh = *(const bf16x8*)(HH + fr * HSTR + ks * 32 + fq * 8), hl = *(const bf16x8*)(HL + fr * HSTR + ks * 32 + fq * 8);
            a0 = MFMA16(wh, hh, a0); a1 = MFMA16(wl, hh, a1); a2 = MFMA16(wh, hl, a2); }
#pragma unroll
        for (int j = 0; j < 4; ++j) LG[fr * 64 + w * 16 + fq * 4 + j] = a0[j] + (a1[j] + a2[j]);
    }
    __syncthreads();
    const int e = lane < NE ? lane : 0;
#pragma unroll 1
    for (int u = 0; u < 4; ++u) { const int tl = w * 4 + u, t = t0 + tl; const bool tv = t < ntok;
        const float sc = sigmoidf_(LG[tl * 64 + e]); const bool ev = lane < NE;
        const float sel = ev ? sc + p->in[I_b_router][l * NE + e] : -3e38f;
        int rk = 0;
#pragma unroll
        for (int d = 1; d < PER; ++d) { float o = __shfl_xor(sel, d); int j = lane ^ d; rk += (o > sel || (o == sel && j < lane)) ? 1 : 0; }
        float gs = rk < 2 ? sel : 0.f;
#pragma unroll
        for (int d = 1; d < PER; d <<= 1) gs += __shfl_xor(gs, d);
        if (!ev) gs = -3e38f;
        int grk = 0; const int g = lane / PER;
#pragma unroll
        for (int d = 1; d < 8; ++d) { float o = __shfl_xor(gs, (d * PER) & 63); int gj = g ^ d; if (PER * 8 == 64 || (lane ^ (d * PER)) < NE) grk += (o > gs || (o == gs && gj < g)) ? 1 : 0; }
        const float v = (ev && grk < 4) ? sel : -3e38f;
        int erk = 0;
        for (int d = 1; d < 64; ++d) { float o = __shfl_xor(v, d); int j = lane ^ d; erk += (o > v || (o == v && j < lane)) ? 1 : 0; }
        const bool chosen = ev && grk < 4 && erk < 8;
        float gsum = wave_sum(chosen ? sc : 0.f);
        if (tv && chosen) { const float gate = sc / gsum * 2.5f; unsigned pos = atomicAdd(&CNT[lane], 1u);
            ((int*)(p->ws + WS_LIST))[(size_t)lane * TT + pos] = t; ((float*)(p->ws + WS_LISTW))[(size_t)lane * TT + pos] = gate;
            ((int*)(p->ws + WS_REF))[(size_t)t * 8 + erk] = (int)((pos << 8) | (unsigned)lane); }
    }
}

DEV void moe_prefix(KP p, char* smem, int l, int ntok) {
    int* TOFF = (int*)(smem + 65536); int* SOFF = TOFF + 80;
    const unsigned* CNT = (const unsigned*)(p->ws + WS_CTL) + CW_CNT + l * (NE + 1);
    __syncthreads();
    if (tidx() == 0) { int ta = 0, sa = 0; for (int e = 0; e <= NE; ++e) { int c = e < NE ? (int)CNT[e] : ntok; TOFF[e] = ta; SOFF[e] = sa; ta += (c + 127) / 128; sa += c; } TOFF[NE + 1] = ta; SOFF[NE + 1] = sa; }
    __syncthreads();
}
DEV void moe_find(const int* TOFF, int tile, int& e, int& mt) { int lo = 0; for (int k = 0; k <= NE; ++k) if (TOFF[k] <= tile) lo = k; e = lo; mt = tile - TOFF[lo]; }
DEV void moe_g1_phase(KP p, char* smem, int l, int ntok) {
    moe_prefix(p, smem, l, ntok);
    const int* TOFF = (const int*)(smem + 65536); const int* SOFF = TOFF + 80;
    constexpr int NNT = DE / 64; const int ntiles = TOFF[NE + 1];
    const unsigned* CNT = (const unsigned*)(p->ws + WS_CTL) + CW_CNT + l * (NE + 1);
    for (int it = vblock(); it < ntiles * NNT; it += gridDim.x) {
        const int tile = it / NNT, nt = it % NNT; int e, mt; moe_find(TOFF, tile, e, mt);
        const int cnt = e < NE ? (int)CNT[e] : ntok; const int nvalid = cnt - mt * 128 < 128 ? cnt - mt * 128 : 128;
        GemmA a{(const bf16*)(p->ws + WS_HA), DM, e < NE ? (const int*)(p->ws + WS_LIST) + (size_t)e * TT + mt * 128 : nullptr, mt * 128, nvalid};
        GemmB bb{(const bf16*)(p->ws + WS_WGU) + ((size_t)e * 2 * DE + nt * 128) * DM, DM};
        EpiG1 epi{(bf16*)(p->ws + WS_ACT), SOFF[e] + mt * 128, nvalid, nt * 64};
        gemm_tile(smem, a, bb, DM, epi);
    }
}
DEV void moe_g2_phase(KP p, char* smem, int l, int ntok) {
    moe_prefix(p, smem, l, ntok);
    const int* TOFF = (const int*)(smem + 65536); const int* SOFF = TOFF + 80;
    constexpr int NNT = DM / 128; const int ntiles = TOFF[NE + 1];
    const unsigned* CNT = (const unsigned*)(p->ws + WS_CTL) + CW_CNT + l * (NE + 1);
    for (int it = vblock(); it < ntiles * NNT; it += gridDim.x) {
        const int tile = it / NNT, nt = it % NNT; int e, mt; moe_find(TOFF, tile, e, mt);
        const int cnt = e < NE ? (int)CNT[e] : ntok; const int nvalid = cnt - mt * 128 < 128 ? cnt - mt * 128 : 128;
        GemmA a{(const bf16*)(p->ws + WS_ACT), DE, nullptr, SOFF[e] + mt * 128, nvalid};
        GemmB bb{(const bf16*)(p->ws + WS_WDN) + ((size_t)e * DM + nt * 128) * DE, DE};
        EpiG2 epi{(bf16*)(p->ws + WS_Y), SOFF[e] + mt * 128, nvalid, nt * 128, e < NE ? (const float*)(p->ws + WS_LISTW) + (size_t)e * TT + mt * 128 : nullptr};
        gemm_tile(smem, a, bb, DE, epi);
    }
}
DEV void combine_phase(KP p, char* smem, int l, int ntok) {
    moe_prefix(p, smem, l, ntok);
    const int* SOFF = (const int*)(smem + 65536) + 80;
    const int lane = tidx() & 63; float* X = (float*)(p->ws + WS_X); const bf16* Y = (const bf16*)(p->ws + WS_Y); const int* REF = (const int*)(p->ws + WS_REF);
    for (int it = blockIdx.x; it < ntok / 4; it += gridDim.x) {
        const int t = it * 4 + (tidx() >> 6);
        f32x4 acc[NV];
#pragma unroll
        for (int i = 0; i < NV; ++i) acc[i] = (f32x4){0.f, 0.f, 0.f, 0.f};
#pragma unroll
        for (int k = 0; k < 9; ++k) { int slot; if (k < 8) { int r = REF[(size_t)t * 8 + k]; slot = SOFF[r & 255] + (int)((unsigned)r >> 8); } else slot = SOFF[NE] + t;
            const bf16* yr = Y + (size_t)slot * DM;
#pragma unroll
            for (int i = 0; i < NV; ++i) { u32x2 u = *(const u32x2*)(yr + i * 256 + lane * 4); acc[i][0] += bflo(u.x); acc[i][1] += bfhi(u.x); acc[i][2] += bflo(u.y); acc[i][3] += bfhi(u.y); } }
        f32x4 v[NV]; load_row(X + (size_t)t * DM, lane, v); const float* g2 = modp(p, l, t, 5);
#pragma unroll
        for (int i = 0; i < NV; ++i) { f32x4 g = *(const f32x4*)(g2 + i * 256 + lane * 4); v[i] = v[i] + g * acc[i]; }
        const float rstd = row_rstd(v);
        if (l == 0) {
#pragma unroll
            for (int i = 0; i < NV; ++i) *(f32x4*)(X + (size_t)t * DM + i * 256 + lane * 4) = v[i];
            f32x4 h[NV]; norm_mod(v, rstd, p->in[I_g_mix] + DM, modp(p, 1, t, 0), modp(p, 1, t, 1), lane, h);
            store_row_bf16((bf16*)(p->ws + WS_HB) + (size_t)t * DM, lane, h);
        } else {
#pragma unroll
            for (int i = 0; i < NV; ++i) { f32x4 g = *(const f32x4*)(p->in[I_g_final] + i * 256 + lane * 4); *(f32x4*)(p->out + (size_t)t * DM + i * 256 + lane * 4) = v[i] * rstd * g; }
        }
    }
}

constexpr int CONV_ITEMS = TT / 32;
DEV void ssdconv_item(KP p, int it) {
    const bf16* PROJ = (const bf16*)(p->ws + WS_PROJ); bf16* U = (bf16*)(p->ws + WS_U); float* DTV = (float*)(p->ws + WS_DTV);
    const int tid = tidx(); const int row0 = it * 32; const bool lat = row0 < TL;
    const int seglen = lat ? SEQ : CTX; const int segrow0 = lat ? (row0 / SEQ) * SEQ : TL + ((row0 - TL) / CTX) * CTX; const int t0 = row0 - segrow0;
    const int c4 = tid * 4; f32x4 w[4], bb = *(const f32x4*)(p->in[I_cd_conv_b] + c4);
#pragma unroll
    for (int j = 0; j < 4; ++j) w[j] = *(const f32x4*)(p->in[I_cd_conv_w] + j * 1024 + c4);
    f32x4 win[4];
    auto ldrow = [&](int t) -> f32x4 { if (t < 0 || t >= seglen) return (f32x4){0.f, 0.f, 0.f, 0.f}; u32x2 u = *(const u32x2*)(PROJ + (size_t)(segrow0 + t) * LDP + 2048 + c4); return (f32x4){bflo(u.x), bfhi(u.x), bflo(u.y), bfhi(u.y)}; };
    win[0] = ldrow(t0 - 1); win[1] = ldrow(t0); win[2] = ldrow(t0 + 1);
    for (int r = 0; r < 32; ++r) { win[3] = ldrow(t0 + r + 2);
        f32x4 a = bb + w[0] * win[0] + w[1] * win[1] + w[2] * win[2] + w[3] * win[3];
        st_bf16x4(U + (size_t)(row0 + r) * 1024 + c4, siluf_(a[0]), siluf_(a[1]), siluf_(a[2]), siluf_(a[3]));
        win[0] = win[1]; win[1] = win[2]; win[2] = win[3]; }
    for (int i = tid; i < 32 * 16; i += 256) { int r = i >> 4, c = i & 15; float raw = bf2f(PROJ[(size_t)(row0 + r) * LDP + 3072 + c]);
        DTV[(size_t)(row0 + r) * 16 + c] = softplusf_(raw + p->in[I_cd_dt_bias][c]); }
}
DEV int ssd_chunk_row0(int b, int c) { return c < NCC ? TL + b * CTX + c * 128 : b * SEQ + (c - NCC) * 128; }
constexpr int TSTR = 136;
constexpr int SSD1_ITEMS = NB * NCH * 8;
DEV void ssd1_item(KP p, char* smem, int it) {
    const bf16* U = (const bf16*)(p->ws + WS_U); const float* DTV = (const float*)(p->ws + WS_DTV);
    const int tid = tidx(), lane = tid & 63, w = tid >> 6, fr = lane & 15, fq = lane >> 4;
    const int h = it % 8, c = (it / 8) % NCH, b = it / (8 * NCH), g = h / 4; const int row0 = ssd_chunk_row0(b, c);
    bf16* XT = (bf16*)smem;
    bf16* BT = XT + 2 * 64 * TSTR;
    float* WGT = (float*)(BT + 128 * TSTR);
    __syncthreads();
    if (tid < 128) { const int d = tid >> 6;
        const float a = -__expf(p->in[I_cd_a_log][d * 8 + h]); const int l0 = lane * 2;
        float dt0 = DTV[(size_t)(row0 + l0) * 16 + d * 8 + h], dt1 = DTV[(size_t)(row0 + l0 + 1) * 16 + d * 8 + h];
        float s = (dt0 + dt1) * a, incl = s;
#pragma unroll
        for (int o = 1; o < 64; o <<= 1) { float v = __shfl_up(incl, o); if (lane >= o) incl += v; }
        const float total = __shfl(incl, 63); const float ex = incl - s;
        if (d == 0) { WGT[l0] = __expf(total - (ex + dt0 * a)) * dt0; WGT[l0 + 1] = __expf(total - incl) * dt1; }
        else { WGT[128 + l0] = __expf(ex) * dt0; WGT[128 + l0 + 1] = __expf(ex + dt0 * a) * dt1; }
        if (lane == 0) ((float*)(p->ws + WS_DEC))[((size_t)(b * NCH + c) * 2 + d) * 8 + h] = __expf(total);
    }
    __syncthreads();
    for (int i = tid; i < 128 * 8; i += 256) { int l = i >> 3, part = i & 7; u32x4 v = *(const u32x4*)(U + (size_t)(row0 + l) * 1024 + h * 64 + part * 8); const float wf = WGT[l], wv = WGT[128 + l];
        unsigned uu[4] = {v.x, v.y, v.z, v.w};
#pragma unroll
        for (int j = 0; j < 8; ++j) { float x = (j & 1) ? bfhi(uu[j >> 1]) : bflo(uu[j >> 1]); int pp = part * 8 + j; XT[(0 * 64 + pp) * TSTR + l] = (bf16)f2bf(x * wf); XT[(1 * 64 + pp) * TSTR + l] = (bf16)f2bf(x * wv); } }
    for (int i = tid; i < 128 * 16; i += 256) { int l = i >> 4, part = i & 15; u32x4 v = *(const u32x4*)(U + (size_t)(row0 + l) * 1024 + 512 + g * 128 + part * 8);
        unsigned uu[4] = {v.x, v.y, v.z, v.w};
#pragma unroll
        for (int j = 0; j < 8; ++j) BT[(part * 8 + j) * TSTR + l] = (bf16)((j & 1) ? (uu[j >> 1] >> 16) : (uu[j >> 1] & 0xffffu)); }
    __syncthreads();
    float* ST = (float*)(p->ws + WS_ST);
#pragma unroll 1
    for (int d = 0; d < 2; ++d) {
        f32x4 acc[8];
#pragma unroll
        for (int nf = 0; nf < 8; ++nf) acc[nf] = (f32x4){0.f, 0.f, 0.f, 0.f};
#pragma unroll
        for (int ks = 0; ks < 4; ++ks) { bf16x8 xa = *(const bf16x8*)(XT + (d * 64 + w * 16 + fr) * TSTR + ks * 32 + fq * 8);
#pragma unroll
            for (int nf = 0; nf < 8; ++nf) { bf16x8 bfm = *(const bf16x8*)(BT + (nf * 16 + fr) * TSTR + ks * 32 + fq * 8); acc[nf] = MFMA16(xa, bfm, acc[nf]); } }
        float* st = ST + (((size_t)(b * NCH + c) * 2 + d) * 8 + h) * 8192;
#pragma unroll
        for (int nf = 0; nf < 8; ++nf)
#pragma unroll
            for (int j = 0; j < 4; ++j) st[(w * 16 + fq * 4 + j) * 128 + nf * 16 + fr] = acc[nf][j];
    }
}
constexpr int SSD2_ITEMS = NB * 2 * 8 * 4;
DEV void ssd2_item(KP p, int it) {
    float* ST = (float*)(p->ws + WS_ST); const float* DEC = (const float*)(p->ws + WS_DEC);
    const int q = it & 3, h = (it >> 2) & 7, d = (it >> 5) & 1, b = it >> 6; const int e0 = q * 2048 + tidx() * 8;
    f32x4 c0 = (f32x4){0.f, 0.f, 0.f, 0.f}, c1 = c0;
    for (int i = 0; i < NCH; ++i) { int c = d == 0 ? i : (i < NCC ? NCC - 1 - i : NCH - 1 - (i - NCC));
        float* st = ST + (((size_t)(b * NCH + c) * 2 + d) * 8 + h) * 8192 + e0; const float dec = DEC[((size_t)(b * NCH + c) * 2 + d) * 8 + h];
        f32x4 s0 = *(f32x4*)st, s1 = *(f32x4*)(st + 4);
        if (c >= NCC) { *(f32x4*)st = c0; *(f32x4*)(st + 4) = c1; }
        c0 = c0 * dec + s0; c1 = c1 * dec + s1; }
}
constexpr int SSD3_ITEMS = NB * NCL * 4;
DEV void ssd3_item(KP p, char* smem, int it) {
    const bf16* U = (const bf16*)(p->ws + WS_U); const float* DTV = (const float*)(p->ws + WS_DTV); const bf16* PROJ = (const bf16*)(p->ws + WS_PROJ); bf16* CAT = (bf16*)(p->ws + WS_CAT);
    const float* ST = (const float*)(p->ws + WS_ST);
    const int tid = tidx(), lane = tid & 63, w = tid >> 6, fr = lane & 15, fq = lane >> 4;
    const int hf = it & 1, g = (it >> 1) & 1, cl = (it >> 2) % NCL, b = it / (4 * NCL); const int c = NCC + cl; const int row0 = b * SEQ + cl * 128;
    const int LF = hf * 4 + w; const int l = LF * 16 + fr;
    bf16* CS = (bf16*)smem;
    bf16* R2 = CS + 128 * TSTR;
    bf16* XT = R2; bf16* HB = R2 + 64 * TSTR;
    float* AC = (float*)(R2 + 128 * TSTR);
    float* DT = AC + 256;
    __syncthreads();
    for (int i = tid; i < 128 * 16; i += 256) { int ll = i >> 4, part = i & 15;
        *(u32x4*)(CS + ll * TSTR + part * 8) = *(const u32x4*)(U + (size_t)(row0 + ll) * 1024 + 768 + g * 128 + part * 8);
        *(u32x4*)(R2 + ll * TSTR + part * 8) = *(const u32x4*)(U + (size_t)(row0 + ll) * 1024 + 512 + g * 128 + part * 8); }
    __syncthreads();
    f32x4 cbt[8];
#pragma unroll
    for (int sf = 0; sf < 8; ++sf) cbt[sf] = (f32x4){0.f, 0.f, 0.f, 0.f};
#pragma unroll
    for (int ks = 0; ks < 4; ++ks) { bf16x8 cf = *(const bf16x8*)(CS + l * TSTR + ks * 32 + fq * 8);
#pragma unroll
        for (int sf = 0; sf < 8; ++sf) { bf16x8 bfm = *(const bf16x8*)(R2 + (sf * 16 + fr) * TSTR + ks * 32 + fq * 8); cbt[sf] = MFMA16(bfm, cf, cbt[sf]); } }
    float ss = 0.f; const size_t row = (size_t)(row0 + l);
#pragma unroll 1
    for (int hh = 0; hh < 4; ++hh) {
        const int h = g * 4 + hh;
        __syncthreads();
        if (tid < 128) { const int d = tid >> 6; const float a = -__expf(p->in[I_cd_a_log][d * 8 + h]); const int l0 = lane * 2;
            float dt0 = DTV[(size_t)(row0 + l0) * 16 + d * 8 + h], dt1 = DTV[(size_t)(row0 + l0 + 1) * 16 + d * 8 + h];
            float s2 = (dt0 + dt1) * a, incl = s2;
#pragma unroll
            for (int o = 1; o < 64; o <<= 1) { float v = __shfl_up(incl, o); if (lane >= o) incl += v; }
            const float total = __shfl(incl, 63), ex = incl - s2;
            if (d == 0) { AC[l0] = ex + dt0 * a; AC[l0 + 1] = incl; } else { AC[128 + l0] = total - ex; AC[128 + l0 + 1] = total - ex - dt0 * a; }
            DT[d * 128 + l0] = dt0; DT[d * 128 + l0 + 1] = dt1; }
        for (int i = tid; i < 128 * 8; i += 256) { int ll = i >> 3, part = i & 7; u32x4 v = *(const u32x4*)(U + (size_t)(row0 + ll) * 1024 + h * 64 + part * 8);
            unsigned uu[4] = {v.x, v.y, v.z, v.w};
#pragma unroll
            for (int j = 0; j < 8; ++j) XT[(part * 8 + j) * TSTR + ll] = (bf16)((j & 1) ? (uu[j >> 1] >> 16) : (uu[j >> 1] & 0xffffu)); }
        __syncthreads();
        f32x4 y[4];
#pragma unroll
        for (int pf = 0; pf < 4; ++pf) y[pf] = (f32x4){0.f, 0.f, 0.f, 0.f};
#pragma unroll
        for (int k2 = 0; k2 < 4; ++k2) {
#pragma unroll 1
            for (int d = 0; d < 2; ++d) {
                const float acl = AC[d * 128 + l]; float wv[8];
#pragma unroll
                for (int jj = 0; jj < 8; ++jj) { const int s = (2 * k2 + (jj >> 2)) * 16 + fq * 4 + (jj & 3);
                    const bool ok = d == 0 ? s <= l : s >= l; const float arg = ok ? acl - AC[d * 128 + s] : -1e30f;
                    wv[jj] = cbt[2 * k2 + (jj >> 2)][jj & 3] * __expf(arg) * DT[d * 128 + s]; }
                bf16x8 wfr = pack8(wv[0], wv[1], wv[2], wv[3], wv[4], wv[5], wv[6], wv[7]);
#pragma unroll
                for (int pf = 0; pf < 4; ++pf) { u32x2 lo = *(const u32x2*)(XT + (pf * 16 + fr) * TSTR + k2 * 32 + fq * 4), hi = *(const u32x2*)(XT + (pf * 16 + fr) * TSTR + k2 * 32 + 16 + fq * 4);
                    u32x4 vv; vv.x = lo.x; vv.y = lo.y; vv.z = hi.x; vv.w = hi.y; bf16x8 xf = __builtin_bit_cast(bf16x8, vv);
                    y[pf] = MFMA16(xf, wfr, y[pf]); }
            }
        }
        { const float dsk = p->in[I_cd_d_skip][h];
#pragma unroll
          for (int pf = 0; pf < 4; ++pf)
#pragma unroll
              for (int j = 0; j < 4; ++j) y[pf][j] += dsk * bf2f(XT[(pf * 16 + fq * 4 + j) * TSTR + l]); }
#pragma unroll 1
        for (int d = 0; d < 2; ++d) {
            __syncthreads();
            const float* hin = ST + (((size_t)(b * NCH + c) * 2 + d) * 8 + h) * 8192;
            for (int i = tid; i < 64 * 32; i += 256) { int pp = i >> 5, n4 = (i & 31) * 4; f32x4 v = *(const f32x4*)(hin + pp * 128 + n4); st_bf16x4(HB + pp * TSTR + n4, v[0], v[1], v[2], v[3]); }
            __syncthreads();
            f32x4 tt[4];
#pragma unroll
            for (int pf = 0; pf < 4; ++pf) tt[pf] = (f32x4){0.f, 0.f, 0.f, 0.f};
#pragma unroll
            for (int ks = 0; ks < 4; ++ks) { bf16x8 cf = *(const bf16x8*)(CS + l * TSTR + ks * 32 + fq * 8);
#pragma unroll
                for (int pf = 0; pf < 4; ++pf) { bf16x8 hfm = *(const bf16x8*)(HB + (pf * 16 + fr) * TSTR + ks * 32 + fq * 8); tt[pf] = MFMA16(hfm, cf, tt[pf]); } }
            const float sc = __expf(AC[d * 128 + l]);
#pragma unroll
            for (int pf = 0; pf < 4; ++pf) y[pf] = y[pf] + tt[pf] * sc;
        }
#pragma unroll
        for (int pf = 0; pf < 4; ++pf) { u32x2 z = *(const u32x2*)(PROJ + row * LDP + 512 + h * 64 + pf * 16 + fq * 4);
            float v0 = y[pf][0] * siluf_(bflo(z.x)), v1 = y[pf][1] * siluf_(bfhi(z.x)), v2 = y[pf][2] * siluf_(bflo(z.y)), v3 = y[pf][3] * siluf_(bfhi(z.y));
            ss += v0 * v0 + v1 * v1 + v2 * v2 + v3 * v3; st_bf16x4(CAT + row * LDC + 512 + h * 64 + pf * 16 + fq * 4, v0, v1, v2, v3); }
    }
    ss += __shfl_xor(ss, 16); ss += __shfl_xor(ss, 32); const float rstd = rsqrtf(ss * (1.0f / 256.0f) + EPS);
#pragma unroll 1
    for (int hh = 0; hh < 4; ++hh)
#pragma unroll
        for (int pf = 0; pf < 4; ++pf) { const int ch = g * 256 + hh * 64 + pf * 16 + fq * 4; f32x4 ng = *(const f32x4*)(p->in[I_cd_norm_g] + ch); u32x2 pk = *(const u32x2*)(CAT + row * LDC + 512 + ch);
            st_bf16x4(CAT + row * LDC + 512 + ch, bflo(pk.x) * rstd * ng[0], bfhi(pk.x) * rstd * ng[1], bflo(pk.y) * rstd * ng[2], bfhi(pk.y) * rstd * ng[3]); }
}

#ifndef HIP_EMU
namespace cg = cooperative_groups;
#define XB_TMO      128
#define XB_XCNT(j)  (256  + 64 * (j))
#define XB_XSUB(j)  (1280 + 64 * (j))
#define XB_XGEN(j)  (2304 + 64 * (j))
#define XB_TOP      3328
#define XB_TOPGEN   3392
#define XCD_BAR_WORDS 3456
#define XB_SPIN_CAP (1u << 20)
DEV unsigned xb_ld(unsigned* p) { return __hip_atomic_load(p, __ATOMIC_RELAXED, __HIP_MEMORY_SCOPE_AGENT); }
DEV unsigned xb_add(unsigned* p, unsigned v) { return __hip_atomic_fetch_add(p, v, __ATOMIC_RELAXED, __HIP_MEMORY_SCOPE_AGENT); }
DEV unsigned xb_xcc_id() { return (unsigned)__builtin_amdgcn_s_getreg((3 << 11) | 20) & 0xFu; }
#define XB_SPIN(cond, bar) do { unsigned _sp = 0; while (cond) { __builtin_amdgcn_s_sleep(1); \
    if ((++_sp & 255u) == 0u) { if (xb_ld(&(bar)[XB_TMO])) break; if (_sp > XB_SPIN_CAP) { atomicAdd(&(bar)[XB_TMO], 1u); break; } } } } while (0)
struct XcdBarrier { unsigned* bar; unsigned x; unsigned* st; };
DEV void xcd_barrier_complete(unsigned* bar, unsigned x, unsigned& nloc, unsigned& nx) {
    const unsigned G = gridDim.x; unsigned sum, cnt, mine, sp = 0u;
    for (;;) { sum = 0u; cnt = 0u; mine = 0u;
#pragma unroll
        for (unsigned j = 0; j < 16; ++j) { const unsigned c = xb_ld(&bar[XB_XCNT(j)]); sum += c; cnt += (c > 0u) ? 1u : 0u; mine = (j == x) ? c : mine; }
        if (sum == G) break;
        __builtin_amdgcn_s_sleep(1);
        if ((++sp & 255u) == 0u) { if (xb_ld(&bar[XB_TMO])) break; if (sp > XB_SPIN_CAP) { atomicAdd(&bar[XB_TMO], 1u); break; } } }
    nloc = mine > 0u ? mine : 1u; nx = cnt > 0u ? cnt : 1u;
}
DEV void xcd_barrier(unsigned* st) {
    asm volatile("s_waitcnt vmcnt(0)" ::: "memory");
    __syncthreads();
    if (threadIdx.x == 0) {
        XcdBarrier b; b.bar = (unsigned*)(kparams()->ws + WS_CTL); b.x = xb_xcc_id(); b.st = st;
        unsigned* bar = b.bar;
        __builtin_amdgcn_s_waitcnt(0);
        unsigned nloc = b.st[0], nx = b.st[1];
        if (nloc == 0u) { xcd_barrier_complete(bar, b.x, nloc, nx); b.st[0] = nloc; b.st[1] = nx; }
        const unsigned old = xb_add(&bar[XB_XSUB(b.x)], 1u);
        const unsigned gen = old / nloc;
        if (old + 1u == (gen + 1u) * nloc) {
            __builtin_amdgcn_fence(__ATOMIC_RELEASE, "agent");
            asm volatile("s_waitcnt vmcnt(0)" ::: "memory");
            const unsigned og = xb_add(&bar[XB_TOP], 1u);
            const unsigned tg = og / nx;
            if (og + 1u == (tg + 1u) * nx) xb_add(&bar[XB_TOPGEN], 1u);
            else XB_SPIN(xb_ld(&bar[XB_TOPGEN]) == tg, bar);
            __builtin_amdgcn_fence(__ATOMIC_ACQUIRE, "agent");
            xb_add(&bar[XB_XGEN(b.x)], 1u);
            asm volatile("s_waitcnt vmcnt(0)" ::: "memory");
        } else {
            XB_SPIN(xb_ld(&bar[XB_XGEN(b.x)]) == gen, bar);
            __builtin_amdgcn_fence(__ATOMIC_ACQUIRE, "agent");
            asm volatile("s_waitcnt vmcnt(0)" ::: "memory");
        }
    }
    __syncthreads();
}
#endif

DEV void ph_prep(KP p, char* smem) {
    constexpr int N0 = 2 * MOD_CG, N1 = N0 + SEQ * 32 / 256, N2 = N1 + WRT_ITEMS, N3 = N2 + 1, N4 = N3 + CVP_ITEMS;
    for (int it = blockIdx.x; it < N4; it += gridDim.x) {
        if (it < N0) mod_item(p, smem, it); else if (it < N1) rope_item(p, it - N0); else if (it < N2) wrt_item(p, it - N1); else if (it < N3) lam_item(p); else conv_proj_item(p, smem, it - N3); }
}
DEV void ph_norm0(KP p, char* smem) { for (int it = blockIdx.x; it < TT / 4; it += gridDim.x) norm0_item(p, it); }
DEV void ph_inproj0(KP p, char* smem) {
    constexpr int NNT = AB_IN / 128;
    for (int it = vblock(); it < (TT / 128) * NNT; it += gridDim.x) { const int nt = it % NNT, mt = it / NNT; const int n0 = nt * 128;
        GemmA a{(const bf16*)(p->ws + WS_HA), DM, nullptr, mt * 128, 128}; GemmB bb{(const bf16*)(p->ws + WS_WPROJ) + WP_ABIN + (size_t)n0 * DM, DM};
        const int ct = n0 < 512 ? CT_GELU : n0 < 1024 ? CT_ROPE_SCALE : n0 < 1536 ? CT_RAW : n0 < 1664 ? CT_ROPE : CT_VT;
        EpiProj epi{p, mt * 128, n0, AB_IN, ct, 1664, 64, 2}; gemm_tile(smem, a, bb, DM, epi); }
}
DEV void ph_att0(KP p, char* smem) { for (int it = blockIdx.x; it < ATT0_LAT + ATT0_CTX; it += gridDim.x) att0_item(p, smem, it); }
DEV void ph_lru(KP p, char* smem, int pass) { for (int it = blockIdx.x; it < LRU_ITEMS; it += gridDim.x) lru_item(p, smem, it, pass); }
DEV void ph_outproj(KP p, char* smem, int layer) {
    const int mtn = layer == 0 ? TT / 128 : TL / 128; constexpr int NNT = DM / 128;
    for (int it = vblock(); it < mtn * NNT; it += gridDim.x) { const int nt = it % NNT, mt = it / NNT;
        GemmA a{(const bf16*)(p->ws + WS_CAT), LDC, nullptr, mt * 128, 128}; GemmB bb{(const bf16*)(p->ws + WS_WPROJ) + (layer == 0 ? WP_ABOUT : WP_CDOUT) + (size_t)nt * 128 * 1024, 1024};
        EpiOut epi{p, mt * 128, nt * 128, layer}; gemm_tile(smem, a, bb, 1024, epi); }
}
DEV void ph_router(KP p, char* smem, int l) { const int ntok = l == 0 ? TT : TL; const int nr = (ntok + 15) / 16;
    for (int it = blockIdx.x; it < nr + CVM_ITEMS; it += gridDim.x) { if (it < nr) router_item(p, smem, it, l, ntok); else conv_moe_item(p, smem, l, it - nr); } }
DEV void ph_inproj1(KP p, char* smem) {
    constexpr int NNT = (CD_IN + 127) / 128, MTL = TL / 128, MTC = TC / 128; constexpr int NIT = MTL * NNT + MTC * (NNT - 8);
    for (int it = vblock(); it < NIT; it += gridDim.x) { int mt, nt; if (it < MTL * NNT) { nt = it % NNT; mt = it / NNT; } else { int j = it - MTL * NNT; nt = 8 + j % (NNT - 8); mt = MTL + j / (NNT - 8); }
        const int n0 = nt * 128;
        GemmA a{(const bf16*)(p->ws + WS_HB), DM, nullptr, mt * 128, 128}; GemmB bb{(const bf16*)(p->ws + WS_WPROJ) + WP_CDIN + (size_t)n0 * DM, DM};
        const int ct = n0 < 512 ? CT_ROPE_SCALE : n0 < 1024 ? CT_RAW : n0 < 1536 ? CT_ROPE : n0 < 2048 ? CT_VT : CT_RAW;
        EpiProj epi{p, mt * 128, n0, CD_IN, ct, 1536, 128, 4}; gemm_tile(smem, a, bb, DM, epi); }
}
DEV void ph_ssdconv(KP p, char* smem) { for (int it = blockIdx.x; it < CONV_ITEMS; it += gridDim.x) ssdconv_item(p, it); }
DEV void ph_att1(KP p, char* smem) { for (int it = blockIdx.x; it < ATT1_N; it += gridDim.x) att1_item(p, smem, it); }
DEV void ph_ssd1(KP p, char* smem) { for (int it = blockIdx.x; it < SSD1_ITEMS; it += gridDim.x) ssd1_item(p, smem, it); }
DEV void ph_ssd2(KP p, char* smem) { for (int it = blockIdx.x; it < SSD2_ITEMS; it += gridDim.x) ssd2_item(p, it); }
DEV void ph_ssd3(KP p, char* smem) { for (int it = blockIdx.x; it < SSD3_ITEMS; it += gridDim.x) ssd3_item(p, smem, it); }

#ifdef ONLY_PHASE
#define PH(k) ((k) == ONLY_PHASE)
#else
#define PH(k) true
#endif
#ifndef REP_MASK
#define REP_MASK 0u
#endif
#ifndef TS_MASK
#define TS_MASK 0u
#endif
#if !defined(HIP_EMU)
#define TSTAMP(k) do { if (TS_MASK != 0u && blockIdx.x == 0 && threadIdx.x == 0) { unsigned long long t_ = __builtin_amdgcn_s_memrealtime(); \
    if ((k) > 0 && ((TS_MASK >> ((k) - 1)) & 1u)) ts_acc += t_ - ts_prev; ts_prev = t_; } } while (0)
#else
#define TSTAMP(k) do {} while (0)
#endif
#define NREP(k) ((((unsigned)(REP_MASK) >> (k)) & 1u) ? 2 : 1)
#define RUN(k, call) do { for (int rep_ = 0; rep_ < NREP(k); ++rep_) { if (PH(k)) { call; } if (rep_ + 1 < NREP(k)) GRID_SYNC(); } } while (0)
__global__ void __launch_bounds__(256, 2) mega(Params p_arg) {
#ifdef HIP_EMU
    char* smem = emu_smem();
#define GRID_SYNC() emu_grid_sync()
#define GRID_SYNC0() emu_grid_sync()
#define KPARG (&p_arg)
#else
    __shared__ __attribute__((aligned(16))) char smem[SMEM_BYTES];
    __shared__ __attribute__((aligned(16))) unsigned bar_st[4];
    if (threadIdx.x < 4) bar_st[threadIdx.x] = 0u;
    __syncthreads();
    if (threadIdx.x == 0) (void)xb_add((unsigned*)(p_arg.ws + WS_CTL) + XB_XCNT(xb_xcc_id()), 1u);
#define GRID_SYNC() xcd_barrier(bar_st)
#define GRID_SYNC0() cg::this_grid().sync()
#define KPARG kparams()
#endif
    unsigned long long ts_prev = 0, ts_acc = 0; TSTAMP(0);
    RUN(0, ph_prep(KPARG, smem));            GRID_SYNC0(); TSTAMP(1);
    RUN(1, ph_norm0(KPARG, smem));           GRID_SYNC(); TSTAMP(2);
    RUN(2, ph_inproj0(KPARG, smem));         GRID_SYNC(); TSTAMP(3);
    RUN(3, ph_att0(KPARG, smem));
    RUN(4, ph_lru(KPARG, smem, 1));          GRID_SYNC(); TSTAMP(5);
    RUN(5, ph_lru(KPARG, smem, 2));          GRID_SYNC(); TSTAMP(6);
    RUN(6, ph_outproj(KPARG, smem, 0));      GRID_SYNC(); TSTAMP(7);
    RUN(7, ph_router(KPARG, smem, 0));       GRID_SYNC(); TSTAMP(8);
    RUN(8, moe_g1_phase(KPARG, smem, 0, TT)); GRID_SYNC(); TSTAMP(9);
    RUN(9, moe_g2_phase(KPARG, smem, 0, TT)); GRID_SYNC(); TSTAMP(10);
    RUN(10, combine_phase(KPARG, smem, 0, TT)); GRID_SYNC(); TSTAMP(11);
    RUN(11, ph_inproj1(KPARG, smem));        GRID_SYNC(); TSTAMP(12);
    RUN(12, ph_ssdconv(KPARG, smem));
    RUN(13, ph_att1(KPARG, smem));           GRID_SYNC(); TSTAMP(14);
    RUN(14, ph_ssd1(KPARG, smem));           GRID_SYNC(); TSTAMP(15);
    RUN(15, ph_ssd2(KPARG, smem));           GRID_SYNC(); TSTAMP(16);
    RUN(16, ph_ssd3(KPARG, smem));           GRID_SYNC(); TSTAMP(17);
    RUN(17, ph_outproj(KPARG, smem, 1));     GRID_SYNC(); TSTAMP(18);
    RUN(18, ph_router(KPARG, smem, 1));      GRID_SYNC(); TSTAMP(19);
    RUN(19, moe_g1_phase(KPARG, smem, 1, TL)); GRID_SYNC(); TSTAMP(20);
    RUN(20, moe_g2_phase(KPARG, smem, 1, TL)); GRID_SYNC(); TSTAMP(21);
    RUN(21, combine_phase(KPARG, smem, 1, TL));
    TSTAMP(22);
#if !defined(HIP_EMU)
    if (TS_MASK != 0u && blockIdx.x == 0 && threadIdx.x == 0) { const unsigned long long t0_ = __builtin_amdgcn_s_memrealtime(); while (__builtin_amdgcn_s_memrealtime() - t0_ < ts_acc) __builtin_amdgcn_s_sleep(8); }
#endif
}

extern "C" void kernel_launch(void* const* d_in, const int* in_sizes, int n_in, void* d_out, int out_size, void* d_ws, size_t ws_size, hipStream_t stream) {
    if (n_in != N_IN || ws_size < WS_TOTAL) { fprintf(stderr, "kernel_launch: bad args n_in=%d ws=%zu need %zu\n", n_in, ws_size, (size_t)WS_TOTAL); return; }
    Params p{};
    for (int i = 0; i < N_IN; ++i) p.in[i] = (const float*)d_in[i];
    p.out = (float*)d_out; p.ws = (char*)d_ws;
    (void)hipMemsetAsync(d_ws, 0, CTL_BYTES, stream);
#ifdef HIP_EMU
    int grid = 8; if (getenv("EMU_GRID")) grid = atoi(getenv("EMU_GRID"));
    emu_launch(mega, dim3(grid), dim3(256), SMEM_BYTES, p);
#else
    static int grid = 0;
    if (!grid) { int dev = 0, cus = 0, per_cu = 0; hipGetDevice(&dev); hipDeviceGetAttribute(&cus, hipDeviceAttributeMultiprocessorCount, dev);
        hipOccupancyMaxActiveBlocksPerMultiprocessor(&per_cu, mega, 256, 0); if (per_cu > 2) per_cu = 2; if (per_cu < 1) per_cu = 1; grid = cus * per_cu; }
    void* args[] = {&p};
    hipError_t e = hipLaunchCooperativeKernel((void*)mega, dim3(grid), dim3(256), args, 0, stream);
    if (e != hipSuccess) fprintf(stderr, "cooperative launch failed: %s (grid %d)\n", hipGetErrorString(e), grid);
#endif
}

#ifdef HIP_EMU
extern "C" void emu_cmp(const char* name, const void* ptr, int rows, int cols, int ld, int is_bf16);
extern "C" void emu_debug_compare(void* d_ws) {
    char* ws = (char*)d_ws;
    emu_cmp("L1_mod", ws + WS_MOD + (size_t)NR * NMOD * DM * 4, NR, NMOD * DM, NMOD * DM, 0);
    emu_cmp("L1_h", ws + WS_HB, TL, DM, DM, 1);
    emu_cmp("L1_cat", ws + WS_CAT, TL, 1024, LDC, 1);
    emu_cmp("L1_x1", ws + WS_X, TL, DM, DM, 0);
}
#endif
```

```cpp
#ifndef HIP_EMU
#include <hip/hip_runtime.h>
#include <hip/hip_cooperative_groups.h>
#endif
#include <cstdio>
#include <cstdint>
#include <cmath>

#ifndef CFG_D
#define CFG_D 1024
#define CFG_B 8
#define CFG_S 2048
#define CFG_C 256
#define CFG_E 64
#define CFG_DE 256
#endif

#define DEV __device__ __forceinline__

constexpr int DM = CFG_D, NB = CFG_B, SEQ = CFG_S, CTX = CFG_C, NE = CFG_E, DE = CFG_DE;
constexpr int TL = NB * SEQ, TC = NB * CTX, TT = TL + TC, KVL = CTX + SEQ;
constexpr int GRIDW = 64;
constexpr int LRUW = 512, LRUB = 8;
constexpr int AB_IN = 1792, CD_IN = 3088;
constexpr int LDP = 3088;
constexpr int LDC = 1024;
constexpr int NMOD = 6, NR = NB + 1;
constexpr int PER = NE / 8;
constexpr int NCC = CTX / 128, NCL = SEQ / 128, NCH = NCC + NCL;
constexpr int LCH = 32;
constexpr int LNC = CTX / LCH, LNL = SEQ / LCH, LNT = LNC + LNL;
constexpr float EPS = 1e-6f;
static_assert(DM % 256 == 0 && SEQ % 128 == 0 && CTX % 128 == 0 && DE % 64 == 0 && NE % 8 == 0 && NE <= 64, "dims");

typedef unsigned short bf16;
typedef short bf16x8 __attribute__((ext_vector_type(8)));
typedef short bf16x4 __attribute__((ext_vector_type(4)));
typedef float f32x4 __attribute__((ext_vector_type(4)));
typedef float f32x2 __attribute__((ext_vector_type(2)));
typedef unsigned u32x4 __attribute__((ext_vector_type(4)));
typedef int i32x8 __attribute__((ext_vector_type(8)));
typedef unsigned u32x2 __attribute__((ext_vector_type(2)));

constexpr size_t al256(size_t x) { return (x + 255) & ~(size_t)255; }
constexpr size_t WS_CTL = 0;
constexpr size_t CTL_BYTES = 65536;
constexpr int CW_CNT = 8192;
constexpr size_t WS_MOD = WS_CTL + CTL_BYTES;
constexpr size_t ZERO_BYTES = al256(CTL_BYTES + (size_t)2 * NR * NMOD * DM * 4);
constexpr size_t WS_ROPE = al256(WS_MOD + (size_t)2 * NR * NMOD * DM * 4);
constexpr size_t WS_SCAL = al256(WS_ROPE + (size_t)SEQ * 64 * 4);
constexpr size_t WS_WRT = al256(WS_SCAL + 256);
constexpr size_t WS_WLR = al256(WS_WRT + (size_t)2 * 2 * NE * DM * 2);
constexpr size_t WS_LSP = al256(WS_WLR + (size_t)2 * 8 * 2 * 64 * 64 * 2);
constexpr size_t WS_REF = al256(WS_LSP + 2 * 512 * 4);
constexpr size_t WS_LIST = al256(WS_REF + (size_t)TT * 8 * 4);
constexpr size_t WS_LISTW = al256(WS_LIST + (size_t)NE * TT * 4);
constexpr size_t WS_WPROJ = al256(WS_LISTW + (size_t)NE * TT * 4);
constexpr size_t WP_ABIN = 0, WP_ABOUT = WP_ABIN + (size_t)AB_IN * DM, WP_CDIN = WP_ABOUT + (size_t)DM * 1024, WP_CDOUT = WP_CDIN + (size_t)3328 * DM, WP_END = WP_CDOUT + (size_t)DM * 1024;
constexpr size_t WS_WDN = al256(WS_WPROJ + WP_END * 2);
constexpr size_t WS_X = al256(WS_WDN + (size_t)(NE + 1) * DM * DE * 2);
constexpr size_t WS_ACT = al256(WS_X + (size_t)TT * DM * 4);
constexpr size_t WS_BIG = al256(WS_ACT + (size_t)TT * 9 * DE * 2);
constexpr size_t WS_HB = WS_ACT;
constexpr size_t WS_STASH = al256(WS_HB + (size_t)TT * DM * 2);
constexpr size_t WS_Y = WS_BIG;
constexpr size_t WS_HA = WS_BIG;
constexpr size_t WS_PROJ = al256(WS_HA + (size_t)TT * DM * 2);
constexpr size_t WS_CAT = al256(WS_PROJ + (size_t)TT * LDP * 2);
constexpr size_t WS_VT = al256(WS_CAT + (size_t)TT * LDC * 2);
constexpr size_t WS_U = al256(WS_VT + (size_t)NB * 4 * 128 * KVL * 2);
constexpr size_t WS_CARRY = al256(WS_U + (size_t)NB * LNT * 4 * 512 * 4);
static_assert((size_t)NB * LNT * 6 * 512 * 4 + 256 <= (size_t)TT * 1024 * 2, "AGG + CARRY fit in U");
constexpr size_t WS_AGG = WS_U;
constexpr size_t WS_DTV = al256(WS_U + (size_t)TT * 1024 * 2);
constexpr size_t WS_ST = al256(WS_DTV + (size_t)TT * 16 * 4);
constexpr size_t WS_LRS = WS_ST;
static_assert((size_t)4 * TT * 512 * 2 <= (size_t)NB * NCH * 2 * 8 * 8192 * 4, "LRS fits in ST");
constexpr size_t WS_DEC = al256(WS_ST + (size_t)NB * NCH * 2 * 8 * 8192 * 4);
constexpr size_t HIN_BYTES = (size_t)NB * NCL * 2 * 8 * 8192 * 2;
constexpr bool HIN_IN_X = HIN_BYTES <= (size_t)TT * DM * 2;
constexpr size_t WS_HIN = HIN_IN_X ? al256(WS_X + (size_t)TT * DM * 2) : al256(WS_DEC + (size_t)NB * NCH * 16 * 4);
constexpr size_t WS_MIXEND = HIN_IN_X ? al256(WS_DEC + (size_t)NB * NCH * 16 * 4) : al256(WS_HIN + HIN_BYTES);
static_assert(!HIN_IN_X || WS_HIN + HIN_BYTES <= WS_ACT, "HIN fits in the free half of X");
constexpr size_t WS_YEND = al256(WS_Y + (size_t)TT * 9 * DM * 2);
constexpr size_t WS_TOTAL = WS_MIXEND > WS_YEND ? WS_MIXEND : WS_YEND;
constexpr size_t WGU_BYTES = (size_t)(NE + 1) * 2 * DE * DM * 2;
constexpr size_t WS_WGU = WS_PROJ;
static_assert(WS_WGU + WGU_BYTES <= WS_TOTAL, "WGU fits");
static_assert((size_t)NB * LNT * 4 * 512 * 4 <= (size_t)TT * 1024 * 2, "AGG fits in U");

constexpr int HALF_LDS = 71680, BAR_ST_OFF = 2 * HALF_LDS, HBAR_OFF = BAR_ST_OFF + 16, SMEM_BYTES = 2 * HALF_LDS + 32;

#ifdef HIP_EMU
#define MFMA16(a, b, c) emu_mfma_16x16x32_bf16(a, b, c)
#define MFMA16F8(a, b, c) emu_mfma_16x16x32_fp8(a, b, c)
#define MFMA16F8X(a, b, c) emu_mfma_16x16x128_fp8(a, b, c)
#define WAIT_VM0() do {} while (0)
#define WAIT_V(n) do {} while (0)
#define WAIT_L(n) do {} while (0)
#define BAR8() __syncthreads()
#define SCHED0() do {} while (0)
#define SETPRIO(n) do {} while (0)
#define LAUNDER(v) do {} while (0)
#define SCHED_GROUP(mask, n) do {} while (0)
DEV void glds16(const void* g, void* l) { emu_glds16(g, l); }
#else
#define MFMA16(a, b, c) __builtin_amdgcn_mfma_f32_16x16x32_bf16(a, b, c, 0, 0, 0)
#define MFMA16F8(a, b, c) __builtin_amdgcn_mfma_f32_16x16x32_fp8_fp8(a, b, c, 0, 0, 0)
#define MFMA16F8X(a, b, c) __builtin_amdgcn_mfma_scale_f32_16x16x128_f8f6f4(a, b, c, 0, 0, 0, 0, 0, 0)
#define WAIT_VM0() asm volatile("s_waitcnt vmcnt(0)" ::: "memory")
#define WAIT_V(n) asm volatile("s_waitcnt vmcnt(" #n ")" ::: "memory")
#define WAIT_L(n) asm volatile("s_waitcnt lgkmcnt(" #n ")" ::: "memory")
#define BAR8() __builtin_amdgcn_s_barrier()
#define SCHED0() __builtin_amdgcn_sched_barrier(0)
#define SETPRIO(n) __builtin_amdgcn_s_setprio(n)
#define LAUNDER(v) asm volatile("" : "+v"(v))
#define SCHED_GROUP(mask, n) __builtin_amdgcn_sched_group_barrier(mask, n, 0)
DEV void glds16(const void* g, void* l) {
    __builtin_amdgcn_global_load_lds((const __attribute__((address_space(1))) unsigned*)g, (__attribute__((address_space(3))) unsigned*)l, 16, 0, 0);
}
#endif

#ifdef HIP_EMU
DEV int tid512() { return (int)threadIdx.x; }
#else
DEV int tid512() { int t = threadIdx.x; asm volatile("" : "+v"(t)); return t; }
#endif
DEV int tidx() { return tid512() & 255; }
DEV int half_id() { return tid512() >> 8; }
#ifdef HIP_EMU
DEV void half_sync(char* hsm) { (void)hsm; emu_half_sync(half_id()); }
#else
DEV void half_sync(char* hsm) {
    unsigned* c = (unsigned*)(hsm - (size_t)half_id() * HALF_LDS + HBAR_OFF) + half_id() * 2;
    asm volatile("s_waitcnt lgkmcnt(0)" ::: "memory");
    if ((tid512() & 63) == 0) {
        const unsigned old = __hip_atomic_fetch_add(c, 1u, __ATOMIC_RELAXED, __HIP_MEMORY_SCOPE_WORKGROUP);
        const unsigned target = (old & ~3u) + 4u;
        while ((int)(__hip_atomic_load(c, __ATOMIC_RELAXED, __HIP_MEMORY_SCOPE_WORKGROUP) - target) < 0) __builtin_amdgcn_s_sleep(1);
    }
    asm volatile("" ::: "memory");
}
#endif
#define FOR_ITEMS(it, N) for (int it##_0 = (int)blockIdx.x * 2, it = 0; it##_0 < (N) && ((it = (it##_0 + half_id() < (N) ? it##_0 + half_id() : (N) - 1)), true); it##_0 += (int)gridDim.x * 2)
#ifdef HIP_EMU
DEV unsigned f2bf(float f) { unsigned u = __builtin_bit_cast(unsigned, f); return (u + 0x7fffu + ((u >> 16) & 1u)) >> 16; }
DEV unsigned pk2(float lo, float hi) { return f2bf(lo) | (f2bf(hi) << 16); }
#else
typedef __bf16 hwbf16x2 __attribute__((ext_vector_type(2)));
DEV unsigned pk2(float lo, float hi) { f32x2 v = {lo, hi}; return __builtin_bit_cast(unsigned, __builtin_convertvector(v, hwbf16x2)); }
DEV unsigned f2bf(float f) { return pk2(f, 0.f) & 0xffffu; }
#endif
DEV float bf2f(unsigned h) { return __builtin_bit_cast(float, h << 16); }
DEV float bflo(unsigned u) { return __builtin_bit_cast(float, u << 16); }
DEV float bfhi(unsigned u) { return __builtin_bit_cast(float, u & 0xffff0000u); }
#ifdef HIP_EMU
DEV float exp2f_(float x) { return exp2f(x); }
#else
DEV float exp2f_(float x) { return __builtin_amdgcn_exp2f(x); }
#endif
#ifdef HIP_EMU
DEV float rcpf_(float x) { return 1.0f / x; }
DEV float sqrtf_(float x) { return sqrtf(x); }
#else
DEV float rcpf_(float x) { return __builtin_amdgcn_rcpf(x); }
DEV float sqrtf_(float x) { return __builtin_amdgcn_sqrtf(x); }
#endif
DEV float sigmoidf_(float x) { return rcpf_(1.0f + exp2f_(-1.4426950408889634f * x)); }
DEV float siluf_(float x) { return x * sigmoidf_(x); }
DEV float softplusf_(float x) { return x > 20.f ? x : log1pf(__expf(x)); }
DEV float geluf_(float x) { float u = 0.7978845608028654f * (x + 0.044715f * x * x * x); float e = exp2f_(-2.885390081777927f * fabsf(u)); float t = (1.0f - e) * rcpf_(1.0f + e); t = u < 0.f ? -t : t; return 0.5f * x * (1.0f + t); }
DEV float wave_sum(float v) {
#pragma unroll
    for (int m = 32; m >= 1; m >>= 1) v += __shfl_xor(v, m);
    return v;
}
DEV bf16x8 pack8(float a0, float a1, float a2, float a3, float a4, float a5, float a6, float a7) {
    u32x4 u; u.x = pk2(a0, a1); u.y = pk2(a2, a3); u.z = pk2(a4, a5); u.w = pk2(a6, a7); return __builtin_bit_cast(bf16x8, u);
}
#ifdef HIP_EMU
DEV unsigned f2e4m3(float x) { unsigned sgn = x < 0.f ? 0x80u : 0u; float a = fabsf(x); if (!(a == a)) return 0x7fu; if (a > 448.f) a = 448.f;
    if (a < 0.0009765625f) return sgn;
    int e; frexpf(a, &e); e -= 1; if (e < -6) e = -6;
    float q = a / ldexpf(1.f, e - 3); float r = nearbyintf(q);
    if (e == -6 && r < 8.f) return sgn | (unsigned)r;
    if (r >= 16.f) { r = 8.f; e += 1; }
    if (e > 8) return sgn | 0x7eu;
    return sgn | ((unsigned)(e + 7) << 3) | ((unsigned)r - 8u); }
DEV float e4m32f(unsigned b) { float sg = (b & 0x80u) ? -1.f : 1.f; int ex = (b >> 3) & 15, m = b & 7; return sg * (ex == 0 ? ldexpf((float)m, -9) : ldexpf((float)(8 + m), ex - 10)); }
DEV unsigned pk4_fp8(float a, float b, float c, float d) { return f2e4m3(a) | (f2e4m3(b) << 8) | (f2e4m3(c) << 16) | (f2e4m3(d) << 24); }
DEV f32x4 un4_fp8(unsigned w) { return (f32x4){e4m32f(w & 255u), e4m32f((w >> 8) & 255u), e4m32f((w >> 16) & 255u), e4m32f(w >> 24)}; }
#else
DEV unsigned pk4_fp8(float a, float b, float c, float d) { int w = 0; w = __builtin_amdgcn_cvt_pk_fp8_f32(a, b, w, false); w = __builtin_amdgcn_cvt_pk_fp8_f32(c, d, w, true); return (unsigned)w; }
DEV f32x4 un4_fp8(unsigned w) { f32x2 lo = __builtin_amdgcn_cvt_pk_f32_fp8((int)w, false), hi = __builtin_amdgcn_cvt_pk_f32_fp8((int)w, true); return (f32x4){lo.x, lo.y, hi.x, hi.y}; }
#endif
constexpr float Y8_SCALE = 16.0f;
DEV void st_bf16x4(bf16* p, float a, float b, float c, float d) { u32x2 u; u.x = pk2(a, b); u.y = pk2(c, d); *(u32x2*)p = u; }
DEV void st_pair_bf16(bf16* rowp, f32x4 a, f32x4 b, int fq4, bool do_store) {
    u32x2 pa, pb; pa.x = pk2(a[0], a[1]); pa.y = pk2(a[2], a[3]); pb.x = pk2(b[0], b[1]); pb.y = pk2(b[2], b[3]);
    const bool odd = (fq4 & 4) != 0;
    u32x2 snd = odd ? pa : pb, rcv; rcv.x = (unsigned)__shfl_xor((int)snd.x, 16); rcv.y = (unsigned)__shfl_xor((int)snd.y, 16);
    u32x4 o; if (odd) { o.x = rcv.x; o.y = rcv.y; o.z = pb.x; o.w = pb.y; } else { o.x = pa.x; o.y = pa.y; o.z = rcv.x; o.w = rcv.y; }
    if (do_store) *(u32x4*)(rowp + (odd ? 16 + fq4 - 4 : fq4)) = o;
}

enum { I_x, I_c, I_ctx, I_c_ctx, I_w_mod, I_b_mod, I_g_mix, I_g_ffn, I_g_final,
       I_ab_w_in, I_ab_w_out, I_ab_conv_w, I_ab_conv_b, I_ab_w_r, I_ab_b_r, I_ab_w_i, I_ab_b_i, I_ab_lam, I_ab_sink,
       I_cd_w_in, I_cd_w_out, I_cd_lam, I_cd_subln_g, I_cd_conv_w, I_cd_conv_b, I_cd_dt_bias, I_cd_a_log, I_cd_d_skip, I_cd_norm_g,
       I_w_router, I_b_router, I_w_e_gate, I_w_e_up, I_w_e_down, I_ws_gate, I_ws_up, I_ws_down, N_IN };

struct Params { const float* in[N_IN]; float* out; char* ws; };
#ifdef HIP_EMU
typedef const Params* KP;
#else
typedef const Params __attribute__((address_space(4))) * KP;
DEV KP kparams() { KP q = (KP)__builtin_amdgcn_kernarg_segment_ptr(); asm volatile("" : "+s"(q)); return q; }
#endif

DEV int mod_row(int t) { return t < TL ? t / SEQ : NB; }
DEV const float* modp(KP p, int l, int t, int which) { return (const float*)(p->ws + WS_MOD) + ((size_t)(l * NR + mod_row(t)) * NMOD + which) * DM; }

constexpr int MOD_CG = NMOD * DM / 32, MOD_ITEMS = 2 * MOD_CG;
DEV void mod_item(KP p, char* smem, int it) {
    const int tid = tidx(), cg = it % MOD_CG, l = it / MOD_CG;
    float* S = (float*)smem;
    float* RED = S + NR * DM;
    half_sync(smem);
    for (int i = tid; i < NR * DM; i += 256) { int r = i / DM, k = i % DM; float v = r < NB ? p->in[I_c][r * DM + k] : p->in[I_c_ctx][k]; S[i] = siluf_(v); }
    half_sync(smem);
    const int col = cg * 32 + (tid & 31), ks = tid >> 5;
    const float* W = p->in[I_w_mod] + (size_t)l * DM * NMOD * DM + col;
    float acc[NR];
#pragma unroll
    for (int r = 0; r < NR; ++r) acc[r] = 0.f;
    for (int k0 = ks * (DM / 8); k0 < (ks + 1) * (DM / 8); k0 += 32) {
        float wv[32];
#pragma unroll
        for (int j = 0; j < 32; ++j) wv[j] = W[(size_t)(k0 + j) * NMOD * DM];
#pragma unroll
        for (int j = 0; j < 32; ++j)
#pragma unroll
            for (int r = 0; r < NR; ++r) acc[r] += S[r * DM + k0 + j] * wv[j];
    }
#pragma unroll
    for (int r = 0; r < NR; ++r) RED[(ks * NR + r) * 32 + (tid & 31)] = acc[r];
    half_sync(smem);
    for (int i = tid; i < NR * 32; i += 256) { int r = i / 32, c = i % 32; float v = 0.f;
#pragma unroll
        for (int q = 0; q < 8; ++q) v += RED[(q * NR + r) * 32 + c];
        int cc = cg * 32 + c; ((float*)(p->ws + WS_MOD))[(size_t)(l * NR + r) * NMOD * DM + cc] = v + p->in[I_b_mod][l * NMOD * DM + cc]; }
}
DEV void rope_item(KP p, int it) {
    int i = it * 256 + tidx();
    if (i < SEQ * 32) { int s = i >> 5, j = i & 31; float pos = (float)(j < 16 ? s / GRIDW : s % GRIDW);
        float inv = powf(10000.0f, -(float)(j & 15) / 16.0f); float ang = pos * inv;
        ((float*)(p->ws + WS_ROPE))[i] = cosf(ang); ((float*)(p->ws + WS_ROPE))[SEQ * 32 + i] = sinf(ang); }
}
constexpr int WRT_ITEMS = 2 * (DM / 64);
DEV void wrt_item(KP p, int it) {
    const int tid = tidx(), l = it / (DM / 64), k0 = (it % (DM / 64)) * 64; bf16* WRT = (bf16*)(p->ws + WS_WRT) + (size_t)l * 2 * NE * DM;
    for (int i = tid; i < 64 * NE; i += 256) { int e = i >> 6, k = k0 + (i & 63); float w = p->in[I_w_router][((size_t)l * DM + k) * NE + e]; unsigned hi = f2bf(w); float lo = w - bf2f(hi);
        WRT[(size_t)e * DM + k] = (bf16)hi; WRT[(size_t)(NE + e) * DM + k] = (bf16)f2bf(lo); }
}
constexpr int WLR_ITEMS = 2 * 8 * 2 * 64 * 64 / 4096;
DEV void wlr_item(KP p, int it) {
    bf16* WLR = (bf16*)(p->ws + WS_WLR);
    for (int j = 0; j < 16; ++j) { const int i = it * 4096 + j * 256 + tidx(); const int c = i & 63, n = (i >> 6) & 63, g = (i >> 12) & 1, blk = (i >> 13) & 7, d = i >> 16;
        WLR[i] = (bf16)f2bf((g ? p->in[I_ab_w_i] : p->in[I_ab_w_r])[((size_t)(d * LRUB + blk) * 64 + c) * 64 + n]); }
}
DEV void lam_item(KP p) {
    { float* LSP = (float*)(p->ws + WS_LSP); for (int i = tidx(); i < 2 * LRUW; i += 256) LSP[i] = softplusf_(-p->in[I_ab_lam][i]); }
    if (tidx() < 64) { const float* lv = p->in[I_cd_lam]; int i = tidx();
        float a = wave_sum(lv[i] * lv[64 + i]), b = wave_sum(lv[128 + i] * lv[192 + i]);
        if (i == 0) { float lam_init = 0.8f - 0.6f * expf(-0.3f); ((float*)(p->ws + WS_SCAL))[0] = expf(a) - expf(b) + lam_init; ((float*)(p->ws + WS_SCAL))[1] = lam_init; } }
}

constexpr int NV = DM / 256;
DEV void load_row(const float* row, int lane, f32x4 (&v)[NV]) {
#pragma unroll
    for (int i = 0; i < NV; ++i) v[i] = *(const f32x4*)(row + i * 256 + lane * 4);
}
DEV void load_row_bf16(const bf16* row, int lane, f32x4 (&v)[NV]) {
#pragma unroll
    for (int i = 0; i < NV; ++i) { u32x2 u = *(const u32x2*)(row + i * 256 + lane * 4); v[i] = (f32x4){bflo(u.x), bfhi(u.x), bflo(u.y), bfhi(u.y)}; }
}
DEV float row_rstd(const f32x4 (&v)[NV]) {
    float ss = 0.f;
#pragma unroll
    for (int i = 0; i < NV; ++i) ss += v[i][0] * v[i][0] + v[i][1] * v[i][1] + v[i][2] * v[i][2] + v[i][3] * v[i][3];
    ss = wave_sum(ss); return rsqrtf(ss * (1.0f / DM) + EPS);
}
DEV void norm_mod(const f32x4 (&v)[NV], float rstd, const float* g, const float* shift, const float* scale, int lane, f32x4 (&h)[NV]) {
#pragma unroll
    for (int i = 0; i < NV; ++i) { int k = i * 256 + lane * 4; f32x4 gg = *(const f32x4*)(g + k), sh = *(const f32x4*)(shift + k), sc = *(const f32x4*)(scale + k);
#pragma unroll
        for (int j = 0; j < 4; ++j) h[i][j] = v[i][j] * rstd * gg[j] * (1.0f + sc[j]) + sh[j]; }
}
DEV void store_row_bf16(bf16* row, int lane, const f32x4 (&h)[NV]) {
#pragma unroll
    for (int i = 0; i < NV; ++i) st_bf16x4(row + i * 256 + lane * 4, h[i][0], h[i][1], h[i][2], h[i][3]);
}
DEV void norm0_range(KP p) {
    const int lane = tidx() & 63, gw = ((int)blockIdx.x * 2 + half_id()) * 4 + (tidx() >> 6), nwv = (int)gridDim.x * 8, per = (TT + nwv - 1) / nwv;
    const int tbeg = gw * per, tend = tbeg + per < TT ? tbeg + per : TT;
    int cur_r = -1; f32x4 gs[NV], sh[NV];
#pragma unroll
    for (int i = 0; i < NV; ++i) { gs[i] = (f32x4){0.f, 0.f, 0.f, 0.f}; sh[i] = gs[i]; }
    f32x4 vn[NV];
    if (tbeg < tend) load_row(tbeg < TL ? p->in[I_x] + (size_t)tbeg * DM : p->in[I_ctx] + (size_t)(tbeg - TL) * DM, lane, vn);
#pragma unroll 1
    for (int t = tbeg; t < tend; ++t) {
        f32x4 v[NV], h[NV];
#pragma unroll
        for (int i = 0; i < NV; ++i) v[i] = vn[i];
        { const int tn = t + 1 < tend ? t + 1 : t; load_row(tn < TL ? p->in[I_x] + (size_t)tn * DM : p->in[I_ctx] + (size_t)(tn - TL) * DM, lane, vn); }
        const float rstd = row_rstd(v);
        if (mod_row(t) != cur_r) { cur_r = mod_row(t); const float* shp = modp(p, 0, t, 0); const float* scp = modp(p, 0, t, 1);
#pragma unroll
            for (int i = 0; i < NV; ++i) { const int k = i * 256 + lane * 4; const f32x4 gg = *(const f32x4*)(p->in[I_g_mix] + k), sc = *(const f32x4*)(scp + k); sh[i] = *(const f32x4*)(shp + k);
#pragma unroll
                for (int j = 0; j < 4; ++j) gs[i][j] = gg[j] * (1.0f + sc[j]); } }
#pragma unroll
        for (int i = 0; i < NV; ++i)
#pragma unroll
            for (int j = 0; j < 4; ++j) h[i][j] = v[i][j] * rstd * gs[i][j] + sh[i][j];
        store_row_bf16((bf16*)(p->ws + WS_HA) + (size_t)t * DM, lane, h);
    }
}

DEV void convT_tile(char* smem, const float* srcA, int ca, const float* srcB, int cb, int lds, int ncol, int k0, bf16* dst, int ldd) {
    float* T = (float*)smem;
    const int tid = tidx();
    half_sync(smem);
    { const int half = tid >> 7, r = (tid >> 3) & 15, c4 = (tid & 7) * 4; const float* src = half ? srcB : srcA; const int c = (half ? cb : ca) + c4;
#pragma unroll
      for (int ps = 0; ps < 4; ++ps) { const int k = r + ps * 16; f32x4 v = (f32x4){0.f, 0.f, 0.f, 0.f};
          if (c + 3 < ncol) v = *(const f32x4*)(src + (size_t)(k0 + k) * lds + c);
          else { for (int j = 0; j < 4; ++j) if (c + j < ncol) v[j] = src[(size_t)(k0 + k) * lds + c + j]; }
          float* tp = T + k * 65 + half * 32 + c4; tp[0] = v[0]; tp[1] = v[1]; tp[2] = v[2]; tp[3] = v[3]; } }
    half_sync(smem);
    { const int n = tid >> 2, kq = (tid & 3) * 16; float v[16];
#pragma unroll
      for (int i = 0; i < 16; ++i) v[i] = T[(kq + i) * 65 + n];
      bf16* d = dst + (size_t)n * ldd + k0 + kq;
      *(bf16x8*)d = pack8(v[0], v[1], v[2], v[3], v[4], v[5], v[6], v[7]); *(bf16x8*)(d + 8) = pack8(v[8], v[9], v[10], v[11], v[12], v[13], v[14], v[15]); }
}
DEV void convT_tile_f8(char* smem, const float* srcA, int ca, const float* srcB, int cb, int lds, int k0, unsigned char* dst, int ldd, float sc) {
    float* T = (float*)smem;
    const int tid = tidx();
    half_sync(smem);
    { const int half = tid >> 7, r = (tid >> 3) & 15, c4 = (tid & 7) * 4; const float* src = half ? srcB : srcA; const int c = (half ? cb : ca) + c4;
#pragma unroll
      for (int ps = 0; ps < 4; ++ps) { const int k = r + ps * 16; f32x4 v = *(const f32x4*)(src + (size_t)(k0 + k) * lds + c);
          float* tp = T + k * 65 + half * 32 + c4; tp[0] = v[0]; tp[1] = v[1]; tp[2] = v[2]; tp[3] = v[3]; } }
    half_sync(smem);
    { const int n = tid >> 2, kq = (tid & 3) * 16; float v[16];
#pragma unroll
      for (int i = 0; i < 16; ++i) v[i] = T[(kq + i) * 65 + n] * sc;
      u32x4 o; o.x = pk4_fp8(v[0], v[1], v[2], v[3]); o.y = pk4_fp8(v[4], v[5], v[6], v[7]); o.z = pk4_fp8(v[8], v[9], v[10], v[11]); o.w = pk4_fp8(v[12], v[13], v[14], v[15]);
      *(u32x4*)(dst + (size_t)n * ldd + k0 + kq) = o; }
}
DEV void conv_plain_item(char* smem, const float* src, int K, int N, bf16* dst, int it) {
    const int kt = it % (K / 64), nt = it / (K / 64);
    convT_tile(smem, src, nt * 64, src, nt * 64 + 32, N, N, kt * 64, dst + (size_t)nt * 64 * K, K);
}
constexpr int CVP_ABIN = (AB_IN / 64) * (DM / 64), CVP_ABOUT = (DM / 64) * (1024 / 64), CVP_CDIN = (3328 / 64) * (DM / 64), CVP_CDOUT = (DM / 64) * (1024 / 64);
constexpr int CVP_ITEMS = CVP_ABIN + CVP_ABOUT + CVP_CDIN + CVP_CDOUT;
DEV void conv_proj_item(KP p, char* smem, int it) {
    bf16* WP = (bf16*)(p->ws + WS_WPROJ);
    if (it < CVP_ABIN) { conv_plain_item(smem, p->in[I_ab_w_in], DM, AB_IN, WP + WP_ABIN, it); return; } it -= CVP_ABIN;
    if (it < CVP_ABOUT) { conv_plain_item(smem, p->in[I_ab_w_out], 1024, DM, WP + WP_ABOUT, it); return; } it -= CVP_ABOUT;
    if (it < CVP_CDIN) { conv_plain_item(smem, p->in[I_cd_w_in], DM, CD_IN, WP + WP_CDIN, it); return; } it -= CVP_CDIN;
    conv_plain_item(smem, p->in[I_cd_w_out], 1024, DM, WP + WP_CDOUT, it);
}
constexpr int CVM_GU = (NE + 1) * (DE / 32) * (DM / 64), CVM_DN = (NE + 1) * (DM / 64) * (DE / 64), CVM_ITEMS = CVM_GU + CVM_DN;
constexpr float WGU_SCALE = 32.0f, WDN_SCALE = 16.0f;
DEV void conv_moe_item(KP p, char* smem, int l, int it) {
    if (it < CVM_GU) { const int kt = it % (DM / 64), j = (it / (DM / 64)) % (DE / 32), e = it / ((DM / 64) * (DE / 32));
        const float* wg = e < NE ? p->in[I_w_e_gate] + ((size_t)l * NE + e) * DM * DE : p->in[I_ws_gate] + (size_t)l * DM * DE;
        const float* wu = e < NE ? p->in[I_w_e_up] + ((size_t)l * NE + e) * DM * DE : p->in[I_ws_up] + (size_t)l * DM * DE;
        convT_tile_f8(smem, wg, j * 32, wu, j * 32, DE, kt * 64, (unsigned char*)(p->ws + WS_WGU) + ((size_t)e * 2 * DE + j * 64) * DM, DM, WGU_SCALE);
    } else { it -= CVM_GU; const int kt = it % (DE / 64), nt = (it / (DE / 64)) % (DM / 64), e = it / ((DE / 64) * (DM / 64));
        const float* wd = e < NE ? p->in[I_w_e_down] + ((size_t)l * NE + e) * DE * DM : p->in[I_ws_down] + (size_t)l * DE * DM;
        convT_tile_f8(smem, wd, nt * 64, wd, nt * 64 + 32, DM, kt * 64, (unsigned char*)(p->ws + WS_WDN) + ((size_t)e * DM + nt * 64) * DE, DE, WDN_SCALE); }
}

struct GemmA { const bf16* A; int lda; const int* list; int row0; int nvalid; };
struct GemmB { const bf16* Bt; int ldb; };
DEV int vblock() { const int G = gridDim.x, b = blockIdx.x; return (G % 8 == 0) ? (b % 8) * (G / 8) + b / 8 : b; }
template <class Job> DEV void gemm512_stream(char* smem, Job& job, int nitems, int K) {
    const int tid = tid512(), lane = tid & 63, wid = tid >> 6, wr = wid >> 2, wc = wid & 3, fr = lane & 15, fq = lane >> 4;
    const int csrc = ((tid & 7) ^ ((tid >> 4) & 7)) * 8;
    const int sw = (fr >> 1) & 7; const int c0 = ((fq ^ sw) * 16), c1 = (((4 + fq) ^ sw) * 16);
    const int offA = (wr * 128 + fr) * 128, offB = 32768 + (wc * 64 + fr) * 128;
    const int nk = K / 64;
    int it = vblock(); if (it >= nitems) return;
    const bf16* pA[4]; const bf16* pB; int ldb;
#define GEMM_SETUP(it_) do { GemmA a_; GemmB b_; job.setup(it_, a_, b_); ldb = b_.ldb; pB = b_.Bt + (size_t)(tid >> 3) * b_.ldb + csrc; \
        _Pragma("unroll") for (int i = 0; i < 4; ++i) { int r = (tid >> 3) + i * 64; int rr = r < a_.nvalid ? r : a_.nvalid - 1; int grow = a_.list ? a_.list[rr] : a_.row0 + rr; pA[i] = a_.A + (size_t)grow * a_.lda + csrc; } } while (0)
#define GEMM_ISSUE(buf_, kt_) do { char* sb_ = smem + (buf_) * 65536 + tid * 16; \
        _Pragma("unroll") for (int i = 0; i < 4; ++i) { glds16(pA[i] + (kt_) * 64, sb_ + i * 8192); glds16(pB + (size_t)i * 64 * ldb + (kt_) * 64, sb_ + 32768 + i * 8192); } } while (0)
    GEMM_SETUP(it);
    __syncthreads();
    int base = 0;
    GEMM_ISSUE(0, 0);
    for (;;) {
        f32x4 acc[8][4];
#pragma unroll
        for (int m = 0; m < 8; ++m)
#pragma unroll
            for (int n = 0; n < 4; ++n) acc[m][n] = (f32x4){0.f, 0.f, 0.f, 0.f};
#define BF_STAGE(kt_, PF_) do { WAIT_VM0(); __syncthreads(); \
            const char* cur = smem + ((base + (kt_)) & 1) * 65536; char* sbn = smem + ((base + (kt_) + 1) & 1) * 65536 + tid * 16; \
            if (PF_) { _Pragma("unroll") for (int i = 0; i < 4; ++i) glds16(pA[i] + ((kt_) + 1) * 64, sbn + i * 8192); } \
            const bf16* pBn = pB + ((kt_) + 1) * 64; \
            _Pragma("unroll") for (int ks = 0; ks < 2; ++ks) { const int cc = ks ? c1 : c0; \
                bf16x8 At[8], Bt[4]; \
                _Pragma("unroll") for (int n = 0; n < 4; ++n) Bt[n] = *(const bf16x8*)(cur + offB + n * 2048 + cc); \
                _Pragma("unroll") for (int m = 0; m < 8; ++m) At[m] = *(const bf16x8*)(cur + offA + m * 2048 + cc); \
                _Pragma("unroll") for (int m = 0; m < 8; ++m) { \
                    _Pragma("unroll") for (int n = 0; n < 4; ++n) acc[m][n] = MFMA16(Bt[n], At[m], acc[m][n]); \
                    if ((PF_) && ks == 0 && (m & 1)) { glds16(pBn, sbn + 32768 + (m >> 1) * 8192); pBn += (size_t)64 * ldb; } } } } while (0)
#pragma unroll 1
        for (int kt = 0; kt + 1 < nk; ++kt) BF_STAGE(kt, true);
        BF_STAGE(nk - 1, false);
#undef BF_STAGE
        base = (base + nk) & 1;
        const int nxt_it = it + (int)gridDim.x; const bool more = nxt_it < nitems;
        if (more) { GEMM_SETUP(nxt_it); GEMM_ISSUE(base, 0); }
        job.epilogue(it, acc, wr * 128 + fr, wc, fq * 4);
        if (!more) break;
        it = nxt_it;
    }
#undef GEMM_SETUP
#undef GEMM_ISSUE
}

DEV void stage_rc8(int b, int& R, int& C) { const int st = b / 1024, sb = b % 1024, swz = sb ^ (((sb >> 9) & 1) << 5); R = (st >> 1) * 16 + swz / 64; C = (st & 1) * 32 + (swz % 64) / 2; }
template <class Job> DEV void gemm512_stream8(char* smem, Job& job, int nitems, int K) {
    const int tid = tid512(), lane = tid & 63, wid = tid >> 6, wr = wid >> 2, wc = wid & 3, fr = lane & 15, fq = lane >> 4;
    constexpr int HT = 16384;
    int offA0[2], offB0[2];
#pragma unroll
    for (int i = 0; i < 2; ++i) { int R, C; stage_rc8(tid * 16 + i * 8192, R, C); offA0[i] = ((R >> 6) * 128 + (R & 63)) * K + C; offB0[i] = ((R >> 5) * 64 + (R & 31)) * K + C; }
    const int swb = (fr * 64 + fq * 16) ^ (((fr >> 3) & 1) << 5);
    const int offLA = (wr * 8) * 1024 + swb, offLB = (wc * 4) * 1024 + swb;
    const int nt = K / 64;
    const bf16* pA0; const bf16* pB0;
#define SA8(b, h) (smem + ((b) * 2 + (h)) * HT)
#define SB8(b, h) (smem + (4 + (b) * 2 + (h)) * HT)
#define STAGE_A(b, h, kt) do { _Pragma("unroll") for (int i_ = 0; i_ < 2; ++i_) { int o_ = offA0[i_], d_ = tid * 16; LAUNDER(o_); LAUNDER(d_); glds16(pA0 + ((h) * 64 * K + (kt) * 64) + o_, SA8(b, h) + d_ + i_ * 8192); } } while (0)
#define STAGE_B(b, h, kt) do { _Pragma("unroll") for (int i_ = 0; i_ < 2; ++i_) { int o_ = offB0[i_], d_ = tid * 16; LAUNDER(o_); LAUNDER(d_); glds16(pB0 + ((h) * 32 * K + (kt) * 64) + o_, SB8(b, h) + d_ + i_ * 8192); } } while (0)
#define LDA8(dst, b, h) do { int o_ = offLA; LAUNDER(o_); const char* s_ = SA8(b, h) + o_; _Pragma("unroll") for (int m_ = 0; m_ < 4; ++m_) _Pragma("unroll") for (int k_ = 0; k_ < 2; ++k_) dst[m_][k_] = *(const bf16x8*)(s_ + (m_ * 2 + k_) * 1024); } while (0)
#define LDB8(dst, b, h) do { int o_ = offLB; LAUNDER(o_); const char* s_ = SB8(b, h) + o_; _Pragma("unroll") for (int n_ = 0; n_ < 2; ++n_) _Pragma("unroll") for (int k_ = 0; k_ < 2; ++k_) dst[n_][k_] = *(const bf16x8*)(s_ + (n_ * 2 + k_) * 1024); } while (0)
#define MMA8(ai, bj, At_, Bt_) do { SETPRIO(1); _Pragma("unroll") for (int m_ = 0; m_ < 4; ++m_) _Pragma("unroll") for (int n_ = 0; n_ < 2; ++n_) _Pragma("unroll") for (int k_ = 0; k_ < 2; ++k_) \
        acc[(ai) * 4 + m_][(bj) * 2 + n_] = MFMA16(Bt_[n_][k_], At_[m_][k_], acc[(ai) * 4 + m_][(bj) * 2 + n_]); SETPRIO(0); } while (0)
    int it = vblock(); if (it >= nitems) return;
#define SETUP8(it_) do { GemmA a_; GemmB b_; job.setup(it_, a_, b_); pB0 = b_.Bt; pA0 = a_.A + (size_t)a_.row0 * a_.lda; } while (0)
    SETUP8(it);
    __syncthreads();
    STAGE_B(0, 0, 0); STAGE_A(0, 0, 0); STAGE_B(0, 1, 0); STAGE_A(0, 1, 0);
    for (;;) {
        f32x4 acc[8][4];
#pragma unroll
        for (int m = 0; m < 8; ++m)
#pragma unroll
            for (int n = 0; n < 4; ++n) acc[m][n] = (f32x4){0.f, 0.f, 0.f, 0.f};
        bf16x8 At[4][2], B0[2][2], B1[2][2];
        if (wr == 1) BAR8();
        WAIT_V(4); BAR8();
        STAGE_B(1, 0, 1); STAGE_A(1, 0, 1); STAGE_B(1, 1, 1);
        WAIT_V(6); BAR8();
#pragma unroll 1
        for (int t = 0; t < nt - 2; t += 2) {
            LDB8(B0, 0, 0); SCHED0(); LDA8(At, 0, 0); STAGE_A(1, 1, t + 1);
            WAIT_L(8); BAR8(); WAIT_L(0); MMA8(0, 0, At, B0); BAR8(); SCHED0();
            LDB8(B1, 0, 1); STAGE_B(0, 0, t + 2);
            BAR8(); WAIT_L(0); MMA8(0, 1, At, B1); BAR8();
            LDA8(At, 0, 1); STAGE_A(0, 0, t + 2);
            BAR8(); WAIT_L(0); MMA8(1, 0, At, B0); BAR8(); SCHED0();
            STAGE_B(0, 1, t + 2);
            WAIT_V(6); BAR8(); MMA8(1, 1, At, B1); BAR8();
            LDB8(B0, 1, 0); SCHED0(); LDA8(At, 1, 0); STAGE_A(0, 1, t + 2);
            WAIT_L(8); BAR8(); WAIT_L(0); MMA8(0, 0, At, B0); BAR8(); SCHED0();
            LDB8(B1, 1, 1); STAGE_B(1, 0, t + 3);
            BAR8(); WAIT_L(0); MMA8(0, 1, At, B1); BAR8();
            LDA8(At, 1, 1); STAGE_A(1, 0, t + 3);
            BAR8(); WAIT_L(0); MMA8(1, 0, At, B0); BAR8(); SCHED0();
            STAGE_B(1, 1, t + 3);
            WAIT_V(6); BAR8(); MMA8(1, 1, At, B1); BAR8();
        }
        { LDB8(B0, 0, 0); LDA8(At, 0, 0); STAGE_A(1, 1, nt - 1);
          BAR8(); WAIT_L(0); MMA8(0, 0, At, B0); BAR8();
          LDB8(B1, 0, 1); BAR8(); WAIT_L(0); MMA8(0, 1, At, B1); BAR8();
          LDA8(At, 0, 1); WAIT_V(4); BAR8(); WAIT_L(0); MMA8(1, 0, At, B0); MMA8(1, 1, At, B1); BAR8(); }
        { LDB8(B0, 1, 0); LDA8(At, 1, 0); WAIT_V(2); BAR8(); WAIT_L(0); MMA8(0, 0, At, B0); BAR8();
          LDB8(B1, 1, 1); WAIT_V(0); BAR8(); WAIT_L(0); MMA8(0, 1, At, B1); BAR8();
          LDA8(At, 1, 1); BAR8(); WAIT_L(0); MMA8(1, 0, At, B0); MMA8(1, 1, At, B1); BAR8(); }
        if (wr == 0) BAR8();
        const int nxt_it = it + (int)gridDim.x; const bool more = nxt_it < nitems;
        if (more) { SETUP8(nxt_it); STAGE_B(0, 0, 0); STAGE_A(0, 0, 0); STAGE_B(0, 1, 0); STAGE_A(0, 1, 0); }
        { int rl0_ = wr * 128 + fr, fq4_ = fq * 4, wc_ = wc; LAUNDER(rl0_); LAUNDER(fq4_); LAUNDER(wc_);
          job.epilogue(it, acc, rl0_, wc_, fq4_); }
        if (!more) break;
        it = nxt_it;
    }
#undef SETUP8
#undef SA8
#undef SB8
#undef STAGE_A
#undef STAGE_B
#undef LDA8
#undef LDB8
#undef MMA8
}

struct GemmA8 { const unsigned char* A; int lda; const int* list; int row0; int nvalid; };
struct GemmB8 { const unsigned char* Bt; int ldb; };
template <class Job, bool ILV> DEV void gemm512_f8_stream(char* smem, Job& job, int nitems, int K) {
    const int tid = tid512(), lane = tid & 63, wid = tid >> 6, wr = wid >> 2, wc = wid & 3, fr = lane & 15, fq = lane >> 4;
    const int csrc = ((tid & 7) ^ ((tid >> 4) & 7)) * 16;
    const int sw = (fr >> 1) & 7;
    const int c0 = ((fq ^ sw) * 16), c1 = (((4 + fq) ^ sw) * 16);
    const int offA = (wr * 128 + fr) * 128, offB = 32768 + (wc * 64 + fr) * 128;
    const int nk = K / 128;
    int it = vblock(); if (it >= nitems) return;
    const unsigned char* pA[4]; const unsigned char* pB; int ldb;
#define GEMM_SETUP(it_) do { GemmA8 a_; GemmB8 b_; job.setup(it_, a_, b_); ldb = b_.ldb; pB = b_.Bt + (size_t)(tid >> 3) * b_.ldb + csrc; \
        _Pragma("unroll") for (int i = 0; i < 4; ++i) { int r = (tid >> 3) + i * 64; int rr = r < a_.nvalid ? r : a_.nvalid - 1; int grow = a_.list ? a_.list[rr] : a_.row0 + rr; pA[i] = a_.A + (size_t)grow * a_.lda + csrc; } } while (0)
#define GEMM_ISSUE(buf_, kt_) do { char* sb_ = smem + (buf_) * 65536 + tid * 16; \
        _Pragma("unroll") for (int i = 0; i < 4; ++i) { glds16(pA[i] + (kt_) * 128, sb_ + i * 8192); glds16(pB + (size_t)i * 64 * ldb + (kt_) * 128, sb_ + 32768 + i * 8192); } } while (0)
    GEMM_SETUP(it);
    __syncthreads();
    int base = 0;
    GEMM_ISSUE(0, 0);
    for (;;) {
        f32x4 acc[8][4];
#pragma unroll
        for (int m = 0; m < 8; ++m)
#pragma unroll
            for (int n = 0; n < 4; ++n) acc[m][n] = (f32x4){0.f, 0.f, 0.f, 0.f};
#define F8_STAGE(kt_, PF_) do { WAIT_VM0(); __syncthreads(); \
            const char* cur = smem + ((base + (kt_)) & 1) * 65536; char* sbn = smem + ((base + (kt_) + 1) & 1) * 65536 + tid * 16; \
            if ((PF_) && !ILV) GEMM_ISSUE((base + (kt_) + 1) & 1, (kt_) + 1); \
            if ((PF_) && ILV) { _Pragma("unroll") for (int i = 0; i < 4; ++i) glds16(pA[i] + ((kt_) + 1) * 128, sbn + i * 8192); } \
            const unsigned char* pBn = pB + ((kt_) + 1) * 128; \
            i32x8 Bt[4]; \
            _Pragma("unroll") for (int n = 0; n < 4; ++n) { const u32x4 lo = *(const u32x4*)(cur + offB + n * 2048 + c0), hi = *(const u32x4*)(cur + offB + n * 2048 + c1); \
                Bt[n] = (i32x8){(int)lo.x, (int)lo.y, (int)lo.z, (int)lo.w, (int)hi.x, (int)hi.y, (int)hi.z, (int)hi.w}; } \
            _Pragma("unroll") for (int mq = 0; mq < 4; ++mq) { i32x8 At[2]; \
                _Pragma("unroll") for (int m = 0; m < 2; ++m) { const u32x4 lo = *(const u32x4*)(cur + offA + (mq * 2 + m) * 2048 + c0), hi = *(const u32x4*)(cur + offA + (mq * 2 + m) * 2048 + c1); \
                    At[m] = (i32x8){(int)lo.x, (int)lo.y, (int)lo.z, (int)lo.w, (int)hi.x, (int)hi.y, (int)hi.z, (int)hi.w}; } \
                _Pragma("unroll") for (int m = 0; m < 2; ++m) { \
                    _Pragma("unroll") for (int n = 0; n < 4; ++n) acc[mq * 2 + m][n] = MFMA16F8X(Bt[n], At[m], acc[mq * 2 + m][n]); \
                    if ((PF_) && ILV && mq < 2) { glds16(pBn, sbn + 32768 + (mq * 2 + m) * 8192); pBn += (size_t)64 * ldb; } } } } while (0)
        if (ILV) {
#pragma unroll 1
            for (int kt = 0; kt + 1 < nk; ++kt) F8_STAGE(kt, true);
            F8_STAGE(nk - 1, false);
        } else {
#pragma unroll 1
            for (int kt = 0; kt < nk; ++kt) F8_STAGE(kt, kt + 1 < nk);
        }
#undef F8_STAGE
        base = (base + nk) & 1;
        const int nxt_it = it + (int)gridDim.x; const bool more = nxt_it < nitems;
        if (more) { GEMM_SETUP(nxt_it); GEMM_ISSUE(base, 0); }
        job.epilogue(it, acc, wr * 128 + fr, wc, fq * 4);
        if (!more) break;
        it = nxt_it;
    }
#undef GEMM_SETUP
#undef GEMM_ISSUE
}

enum { CT_RAW = 0, CT_GELU = 1, CT_ROPE_SCALE = 2, CT_ROPE = 3, CT_VT = 4 };
struct EpiProj {
    KP p; int row0; int nw0; int N; int ctype; int vcol0; int vdim; int vheads;
    DEV void operator()(f32x4 (&acc)[8][4], int rl0, int fq4) const {
        bf16* PROJ = (bf16*)(p->ws + WS_PROJ);
        const float* RC = (const float*)(p->ws + WS_ROPE); const float* RS = RC + SEQ * 32;
#pragma unroll
        for (int m = 0; m < 8; ++m) {
            const int t = row0 + rl0 + m * 16; const bool lat = t < TL; const int s = lat ? t % SEQ : 0;
            if (ctype == CT_ROPE_SCALE || ctype == CT_ROPE) {
                const float sc = ctype == CT_ROPE_SCALE ? 0.125f * 1.4426950408889634f : 1.0f;
#pragma unroll
                for (int n = 0; n < 2; ++n) {
                    f32x4 x1 = acc[m][n], x2 = acc[m][n + 2], o1, o2;
                    if (lat) { const int i0 = n * 16 + fq4; f32x4 c = *(const f32x4*)(RC + s * 32 + i0), sn = *(const f32x4*)(RS + s * 32 + i0);
#pragma unroll
                        for (int j = 0; j < 4; ++j) { o1[j] = (x1[j] * c[j] - x2[j] * sn[j]) * sc; o2[j] = (x1[j] * sn[j] + x2[j] * c[j]) * sc; } }
                    else { o1 = x1 * sc; o2 = x2 * sc; }
                    acc[m][n] = o1; acc[m][n + 2] = o2;
                }
            }
            if (ctype == CT_VT) {
                const int b = lat ? t / SEQ : (t - TL) / CTX; const int kk_ = lat ? CTX + s : (t - TL) % CTX;
                const int kk = (kk_ & ~31) | (((kk_ >> 2) & 3) << 3) | (((kk_ >> 4) & 1) << 2) | (kk_ & 3);
                bf16* VT = (bf16*)(p->ws + WS_VT);
#pragma unroll
                for (int n = 0; n < 4; ++n) { const int c = nw0 + n * 16 + fq4; f32x4 v = acc[m][n];
#pragma unroll
                    for (int j = 0; j < 4; ++j) { int cv = c - vcol0 + j; int hh = cv / vdim, d = cv % vdim; VT[((size_t)(b * vheads + hh) * vdim + d) * KVL + kk] = (bf16)f2bf(v[j]); } }
            } else {
#pragma unroll
                for (int n = 0; n < 4; n += 2) { f32x4 v0 = acc[m][n], v1 = acc[m][n + 1];
                    if (ctype == CT_GELU) {
#pragma unroll
                        for (int j = 0; j < 4; ++j) { v0[j] = geluf_(v0[j]); v1[j] = geluf_(v1[j]); } }
                    st_pair_bf16(PROJ + (size_t)t * LDP + nw0 + n * 16, v0, v1, fq4, nw0 + n * 16 + ((fq4 & 4) ? 16 + fq4 - 4 : fq4) + 8 <= N); }
            }
        }
    }
};
struct EpiOut {
    KP p; int row0; int nw0; int layer;
    DEV void operator()(f32x4 (&acc)[8][4], int rl0, int fq4) const {
        bf16* X = (bf16*)(p->ws + WS_X);
        int cur_r = -1; f32x4 g1v[4];
#pragma unroll
        for (int n = 0; n < 4; ++n) g1v[n] = (f32x4){0.f, 0.f, 0.f, 0.f};
#pragma unroll
        for (int mp = 0; mp < 4; ++mp) { f32x4 xi[2][4];
#pragma unroll
            for (int mm = 0; mm < 2; ++mm) { const int t = row0 + rl0 + (mp * 2 + mm) * 16;
#pragma unroll
                for (int n = 0; n < 4; ++n) { const int c = nw0 + n * 16 + fq4;
                    if (layer == 0) xi[mm][n] = *(const f32x4*)((t < TL ? p->in[I_x] + (size_t)t * DM : p->in[I_ctx] + (size_t)(t - TL) * DM) + c);
                    else { u32x2 u = *(const u32x2*)(X + (size_t)t * DM + c); xi[mm][n] = (f32x4){bflo(u.x), bfhi(u.x), bflo(u.y), bfhi(u.y)}; } } }
#pragma unroll
            for (int mm = 0; mm < 2; ++mm) { const int m = mp * 2 + mm, t = row0 + rl0 + m * 16; f32x4 o[4];
                if (mod_row(t) != cur_r) { cur_r = mod_row(t); const float* g1 = modp(p, layer, t, 2);
#pragma unroll
                    for (int n = 0; n < 4; ++n) g1v[n] = *(const f32x4*)(g1 + nw0 + n * 16 + fq4); }
#pragma unroll
                for (int n = 0; n < 4; ++n) o[n] = xi[mm][n] + g1v[n] * acc[m][n];
                st_pair_bf16(X + (size_t)t * DM + nw0, o[0], o[1], fq4, true); st_pair_bf16(X + (size_t)t * DM + nw0 + 32, o[2], o[3], fq4, true); } }
    }
};
struct EpiG1 {
    unsigned char* ACT; int slot0; int nvalid; int hw0;
    DEV void operator()(f32x4 (&acc)[8][4], int rl0, int fq4) const {
        const int fq = fq4 >> 2; const bool b0 = fq & 1;
#pragma unroll
        for (int m = 0; m < 8; ++m) { const int rl = rl0 + m * 16; const bool ok = rl < nvalid; f32x4 a0, a1;
#pragma unroll
            for (int j = 0; j < 4; ++j) { a0[j] = siluf_(acc[m][0][j] * (1.0f / WGU_SCALE)) * acc[m][2][j] * (1.0f / WGU_SCALE); a1[j] = siluf_(acc[m][1][j] * (1.0f / WGU_SCALE)) * acc[m][3][j] * (1.0f / WGU_SCALE);
                a0[j] = fminf(fmaxf(a0[j], -440.f), 440.f); a1[j] = fminf(fmaxf(a1[j], -440.f), 440.f); }
            const unsigned d0 = pk4_fp8(a0[0], a0[1], a0[2], a0[3]), d1 = pk4_fp8(a1[0], a1[1], a1[2], a1[3]);
            const unsigned r = (unsigned)__shfl_xor((int)(b0 ? d0 : d1), 16);
            const unsigned p0 = b0 ? r : d0, p1 = b0 ? d1 : r;
            const unsigned q0 = (unsigned)__shfl_xor((int)p0, 32), q1 = (unsigned)__shfl_xor((int)p1, 32);
            if (ok && fq < 2) { u32x4 o; o.x = p0; o.y = p1; o.z = q0; o.w = q1; *(u32x4*)(ACT + (size_t)(slot0 + rl) * DE + hw0 + fq * 16) = o; } }
    }
};
struct EpiG2 {
    unsigned char* Y; int slot0; int nvalid; int nw0; const float* w;
    DEV void operator()(f32x4 (&acc)[8][4], int rl0, int fq4) const {
        const int fq = fq4 >> 2; const bool b0 = fq & 1, b1 = (fq & 2) != 0;
        float wws[8];
#pragma unroll
        for (int m = 0; m < 8; ++m) { const int rl = rl0 + m * 16; wws[m] = ((w && rl < nvalid) ? w[rl] : 1.0f) * (Y8_SCALE / WDN_SCALE); }
#pragma unroll
        for (int m = 0; m < 8; ++m) { const int rl = rl0 + m * 16; const bool ok = rl < nvalid; const float ww = wws[m];
            unsigned d[4];
#pragma unroll
            for (int n = 0; n < 4; ++n) { f32x4 v = acc[m][n] * ww;
#pragma unroll
                for (int j = 0; j < 4; ++j) v[j] = fminf(fmaxf(v[j], -440.f), 440.f);
                d[n] = pk4_fp8(v[0], v[1], v[2], v[3]); }
            const unsigned s0 = b0 ? d[0] : d[1], s1 = b0 ? d[2] : d[3];
            const unsigned r0 = (unsigned)__shfl_xor((int)s0, 16), r1 = (unsigned)__shfl_xor((int)s1, 16);
            unsigned lo0, lo1, hi0, hi1;
            if (b0) { lo0 = r0; lo1 = d[1]; hi0 = r1; hi1 = d[3]; } else { lo0 = d[0]; lo1 = r0; hi0 = d[2]; hi1 = r1; }
            const unsigned t0 = b1 ? lo0 : hi0, t1 = b1 ? lo1 : hi1;
            const unsigned q0 = (unsigned)__shfl_xor((int)t0, 32), q1 = (unsigned)__shfl_xor((int)t1, 32);
            u32x4 o; if (b1) { o.x = q0; o.y = q1; o.z = hi0; o.w = hi1; } else { o.x = lo0; o.y = lo1; o.z = q0; o.w = q1; }
            if (ok) *(u32x4*)(Y + (size_t)(slot0 + rl) * DM + nw0 + fq * 16) = o; }
    }
};

#ifndef LAZY_T
#define LAZY_T 6.0f
#endif
template <int DV, bool WINDOW, bool LOCK = false>
DEV void flash_block(char* smem, const bf16* Qp, int ldq, const bf16* Kbase, int ldk, int ctx_row0, int lat_row0, const bf16* VTp,
                     int r0a, int r1a, int r0b, int r1b, int q0, float m_init, float l_init, f32x4 (&o)[DV / 16][2]) {
    constexpr int STG = 8192 + DV * 128;
    constexpr int RPR = LOCK ? 64 : 32;
    const int tid = LOCK ? tid512() : tidx(), lane = tid & 63, w = tid >> 6, fr = lane & 15, fq = lane >> 4;
    const int csw = ((tid & 7) ^ ((tid >> 4) & 7)) * 8;
    const int swr = (fr >> 1) & 7;
    bf16x8 qfr[2][2];
#pragma unroll
    for (int qf = 0; qf < 2; ++qf)
#pragma unroll
        for (int ks = 0; ks < 2; ++ks) qfr[qf][ks] = *(const bf16x8*)(Qp + (size_t)(w * 32 + qf * 16 + fr) * ldq + ks * 32 + fq * 8);
    bool first = m_init < -1e29f;
    float rref[2] = {first ? 0.f : m_init, first ? 0.f : m_init}; const float l0 = fq == 0 ? l_init : 0.f; float lrow[2] = {l0, l0};
#pragma unroll
    for (int df = 0; df < DV / 16; ++df) { o[df][0] = (f32x4){0.f, 0.f, 0.f, 0.f}; o[df][1] = (f32x4){0.f, 0.f, 0.f, 0.f}; }
    const int nta = (r1a - r0a) >> 6, ntb = (r1b - r0b) >> 6, nt = nta + ntb;
#define FL_ISSUE(j_) do { const int kk0_ = (j_) < nta ? r0a + (j_) * 64 : r0b + ((j_) - nta) * 64; char* st_ = smem + ((j_) & 1) * STG + tid * 16; \
        _Pragma("unroll") for (int i = 0; i < 64 / RPR; ++i) { const int key = (tid >> 3) + i * RPR, kk = kk0_ + key; const int row = kk < CTX ? ctx_row0 + kk : lat_row0 + kk - CTX; \
            glds16(Kbase + (size_t)row * ldk + csw, st_ + i * RPR * 128); } \
        _Pragma("unroll") for (int i = 0; i < DV / RPR; ++i) { const int d = (tid >> 3) + i * RPR; glds16(VTp + (size_t)d * KVL + kk0_ + csw, st_ + 8192 + i * RPR * 128); } } while (0)
#define FL_SYNC() do { if (LOCK) __syncthreads(); else half_sync(smem); } while (0)
    FL_SYNC();
    FL_ISSUE(0);
#pragma unroll 1
    for (int jt = 0; jt < nt; ++jt) {
        WAIT_VM0(); FL_SYNC();
        if (jt + 1 < nt) FL_ISSUE(jt + 1);
        const int kk0 = jt < nta ? r0a + jt * 64 : r0b + (jt - nta) * 64;
        const char* SK = smem + (jt & 1) * STG; const char* SV = SK + 8192;
        if (WINDOW && kk0 >= CTX) { const int kp0 = kk0 - CTX, qlo = q0 + w * 32;
            if (kp0 + 63 < qlo - 128 || kp0 > qlo + 31 + 128) continue; }
        f32x4 s[4][2];
#pragma unroll
        for (int kf = 0; kf < 4; ++kf) { s[kf][0] = (f32x4){-rref[0], -rref[0], -rref[0], -rref[0]}; s[kf][1] = (f32x4){-rref[1], -rref[1], -rref[1], -rref[1]};
#pragma unroll
            for (int ks = 0; ks < 2; ++ks) { bf16x8 kfrag = *(const bf16x8*)(SK + (kf * 16 + fr) * 128 + (((ks * 4 + fq) ^ swr) * 16));
                s[kf][0] = MFMA16(kfrag, qfr[0][ks], s[kf][0]); s[kf][1] = MFMA16(kfrag, qfr[1][ks], s[kf][1]); } }
        if (WINDOW && kk0 >= CTX) {
#pragma unroll
            for (int kf = 0; kf < 4; ++kf)
#pragma unroll
                for (int qf = 0; qf < 2; ++qf)
#pragma unroll
                    for (int j = 0; j < 4; ++j) { int kpos = kk0 - CTX + kf * 16 + fq * 4 + j, qpos = q0 + w * 32 + qf * 16 + fr; int dd = qpos - kpos; if (dd > 128 || dd < -128) s[kf][qf][j] = -1e30f; }
        }
        float tml[2];
#pragma unroll
        for (int qf = 0; qf < 2; ++qf) { float tm = -1e30f;
#pragma unroll
            for (int kf = 0; kf < 4; ++kf)
#pragma unroll
                for (int j = 0; j < 4; ++j) tm = fmaxf(tm, s[kf][qf][j]);
            tml[qf] = tm; }
        if (first || __any(fmaxf(tml[0], tml[1]) > LAZY_T)) {
#pragma unroll
            for (int qf = 0; qf < 2; ++qf) {
                float tm = tml[qf]; tm = fmaxf(tm, __shfl_xor(tm, 16)); tm = fmaxf(tm, __shfl_xor(tm, 32));
                const float delta = first ? tm : fmaxf(tm, 0.f), alpha = first ? 0.f : exp2f_(-delta);
                rref[qf] += delta; lrow[qf] *= alpha;
#pragma unroll
                for (int kf = 0; kf < 4; ++kf)
#pragma unroll
                    for (int j = 0; j < 4; ++j) s[kf][qf][j] -= delta;
#pragma unroll
                for (int df = 0; df < DV / 16; ++df) o[df][qf] = o[df][qf] * alpha; }
            first = false;
        }
        bf16x8 pfr[2][2];
#pragma unroll
        for (int qf = 0; qf < 2; ++qf) {
            float rs = 0.f;
#pragma unroll
            for (int kf = 0; kf < 4; ++kf)
#pragma unroll
                for (int j = 0; j < 4; ++j) { float e = exp2f_(s[kf][qf][j]); s[kf][qf][j] = e; rs += e; }
            lrow[qf] += rs;
#pragma unroll
            for (int k2 = 0; k2 < 2; ++k2) pfr[qf][k2] = pack8(s[2 * k2][qf][0], s[2 * k2][qf][1], s[2 * k2][qf][2], s[2 * k2][qf][3], s[2 * k2 + 1][qf][0], s[2 * k2 + 1][qf][1], s[2 * k2 + 1][qf][2], s[2 * k2 + 1][qf][3]);
        }
#pragma unroll
        for (int df = 0; df < DV / 16; ++df)
#pragma unroll
            for (int k2 = 0; k2 < 2; ++k2) { bf16x8 vfrag = *(const bf16x8*)(SV + (df * 16 + fr) * 128 + (((k2 * 4 + fq) ^ swr) * 16));
                o[df][0] = MFMA16(vfrag, pfr[0][k2], o[df][0]); o[df][1] = MFMA16(vfrag, pfr[1][k2], o[df][1]);
            }
    }
#undef FL_ISSUE
#undef FL_SYNC
#pragma unroll
    for (int qf = 0; qf < 2; ++qf) { float l = lrow[qf]; l += __shfl_xor(l, 16); l += __shfl_xor(l, 32); const float inv = rcpf_(l);
#pragma unroll
        for (int df = 0; df < DV / 16; ++df) o[df][qf] = o[df][qf] * inv; }
}

constexpr int ATT0_LAT = NB * NCL * 8, ATT0_CTX = NB * NCC * 8;
DEV void att0_item(KP p, char* smem, int it) {
    const bf16* PROJ = (const bf16*)(p->ws + WS_PROJ); bf16* CAT = (bf16*)(p->ws + WS_CAT);
    const bool isctx = it >= ATT0_LAT; if (isctx) it -= ATT0_LAT;
    const int nqb = isctx ? NCC : NCL; const int h = it % 8, qb = (it / 8) % nqb, b = it / (8 * nqb);
    const int qrow0 = isctx ? TL + b * CTX + qb * 128 : b * SEQ + qb * 128;
    const int lo = qb * 128 - 128 < 0 ? 0 : qb * 128 - 128, hi = qb * 128 + 256 > SEQ ? SEQ : qb * 128 + 256;
    f32x4 o[4][2];
    const bf16* Qp = PROJ + (size_t)qrow0 * LDP + 512 + h * 64; const bf16* Kb = PROJ + 1536 + (h / 4) * 64;
    const bf16* VTp = (const bf16*)(p->ws + WS_VT) + (size_t)(b * 2 + h / 4) * 64 * KVL; const float sink = p->in[I_ab_sink][h] * 1.4426950408889634f;
    if (isctx) flash_block<64, false>(smem, Qp, LDP, Kb, LDP, TL + b * CTX, b * SEQ, VTp, 0, CTX, 0, 0, 0, sink, 1.0f, o);
    else flash_block<64, true>(smem, Qp, LDP, Kb, LDP, TL + b * CTX, b * SEQ, VTp, 0, CTX, CTX + lo, CTX + hi, qb * 128, sink, 1.0f, o);
    const int lane = tidx() & 63, w = tidx() >> 6, fr = lane & 15, fq = lane >> 4;
#pragma unroll
    for (int qf = 0; qf < 2; ++qf)
#pragma unroll
        for (int df = 0; df < 4; ++df) st_bf16x4(CAT + (size_t)(qrow0 + w * 32 + qf * 16 + fr) * LDC + 512 + h * 64 + df * 16 + fq * 4, o[df][qf][0], o[df][qf][1], o[df][qf][2], o[df][qf][3]);
}
constexpr int ATT1_N = NB * (NCL / 2) * 4;
static_assert(NCL % 2 == 0, "att1 pairs q blocks");
DEV void att1_item(KP p, char* smem0, int it) {
    const bf16* PROJ = (const bf16*)(p->ws + WS_PROJ); bf16* CAT = (bf16*)(p->ws + WS_CAT);
    const int h = it % 4, qbp = (it / 4) % (NCL / 2), b = it / (4 * (NCL / 2)); const int qrow0 = b * SEQ + qbp * 256;
    const bf16* VTp = (const bf16*)(p->ws + WS_VT) + (size_t)(b * 4 + h) * 128 * KVL;
    f32x4 o0[8][2], o1[8][2];
    flash_block<128, false, true>(smem0, PROJ + (size_t)qrow0 * LDP + h * 128, LDP, PROJ + 1024 + h * 128, LDP, TL + b * CTX, b * SEQ, VTp, 0, KVL, 0, 0, 0, -1e30f, 0.f, o0);
    u32x2* stash = (u32x2*)(p->ws + WS_STASH) + (size_t)(blockIdx.x * 2 + half_id()) * 4096 + tidx();
#pragma unroll
    for (int df = 0; df < 8; ++df)
#pragma unroll
        for (int qf = 0; qf < 2; ++qf) { u32x2 pk; pk.x = pk2(o0[df][qf][0], o0[df][qf][1]); pk.y = pk2(o0[df][qf][2], o0[df][qf][3]); stash[(df * 2 + qf) * 256] = pk; }
    flash_block<128, false, true>(smem0, PROJ + (size_t)qrow0 * LDP + h * 128 + 64, LDP, PROJ + 1024 + h * 128 + 64, LDP, TL + b * CTX, b * SEQ, VTp, 0, KVL, 0, 0, 0, -1e30f, 0.f, o1);
    const float lam = ((const float*)(p->ws + WS_SCAL))[0], lam_init = ((const float*)(p->ws + WS_SCAL))[1];
    const int lane = tid512() & 63, w = tid512() >> 6, fr = lane & 15, fq = lane >> 4;
    const float* sg = p->in[I_cd_subln_g];
#pragma unroll
    for (int qf = 0; qf < 2; ++qf) {
        float ss = 0.f;
#pragma unroll
        for (int df = 0; df < 8; ++df) { u32x2 pk = stash[(df * 2 + qf) * 256]; o0[df][qf] = (f32x4){bflo(pk.x), bfhi(pk.x), bflo(pk.y), bfhi(pk.y)} - o1[df][qf] * lam;
#pragma unroll
            for (int j = 0; j < 4; ++j) ss += o0[df][qf][j] * o0[df][qf][j]; }
        ss += __shfl_xor(ss, 16); ss += __shfl_xor(ss, 32);
        const float sc = rsqrtf(ss * (1.0f / 128.0f) + EPS) * (1.0f - lam_init);
#pragma unroll
        for (int df = 0; df < 8; ++df) { f32x4 g = *(const f32x4*)(sg + df * 16 + fq * 4); f32x4 v = o0[df][qf] * sc * g;
            st_bf16x4(CAT + (size_t)(qrow0 + w * 32 + qf * 16 + fr) * LDC + h * 128 + df * 16 + fq * 4, v[0], v[1], v[2], v[3]); }
    }
}

constexpr int LRU_ITEMS = NB * LNT * LRUB;
constexpr int LRUC_ITEMS = NB * 2 * (LRUB / 4);
DEV void lru_carry_item(KP p, int it) {
    const float* AGG = (const float*)(p->ws + WS_AGG); float* CARRY = (float*)(p->ws + WS_CARRY);
    const int q = it % (LRUB / 4), d = (it / (LRUB / 4)) & 1, b = it / (2 * (LRUB / 4)); const int gc = q * 256 + tidx();
    float h = 0.f;
    constexpr int CB = 24;
    for (int q0 = 0; q0 < LNT; q0 += CB) { float aa[CB], hh[CB]; int cc[CB];
#pragma unroll
        for (int j = 0; j < CB; ++j) { const int qq = q0 + j < LNT ? q0 + j : LNT - 1; cc[j] = d == 0 ? qq : (qq < LNC ? LNC - 1 - qq : LNT - 1 - (qq - LNC));
            const float* ag = AGG + ((size_t)(b * LNT + cc[j]) * 2 + d) * 1024; aa[j] = ag[gc]; hh[j] = ag[512 + gc]; }
#pragma unroll
        for (int j = 0; j < CB; ++j) if (q0 + j < LNT) { CARRY[((size_t)(b * LNT + cc[j]) * 2 + d) * 512 + gc] = h; h = aa[j] * h + hh[j]; } }
}
struct LruW { int blk; float cwv[4]; float cbv; bf16x8 wfr[2][2][2]; f32x4 cbr[2], cbi[2], csp[2]; };
DEV void lru_xa_request(KP p, int it, u32x4 (&xav)[2]) {
    const bf16* PROJ = (const bf16*)(p->ws + WS_PROJ); const int tid = tidx();
    const int blk = it % LRUB, ck = (it / LRUB) % LNT, b = it / (LRUB * LNT);
    const bool isctx = ck < LNC; const int cs = isctx ? ck : ck - LNC;
    const int seglen = isctx ? CTX : SEQ; const int segrow0 = isctx ? TL + b * CTX : b * SEQ; const int t0 = cs * LCH;
#pragma unroll
    for (int k = 0; k < 2; ++k) { const int i = tid + k * 256; const int r = i >> 3, part = i & 7, t = t0 - 1 + r; xav[k] = (u32x4){0u, 0u, 0u, 0u};
        if (i < (LCH + 3) * 8 && t >= 0 && t < seglen) xav[k] = *(const u32x4*)(PROJ + (size_t)(segrow0 + t) * LDP + 1024 + blk * 64 + part * 8); }
}
DEV void lru_item(KP p, char* smem, int it, int pass, u32x4 (&xav)[2], int it_next, LruW& W) {
    const bf16* PROJ = (const bf16*)(p->ws + WS_PROJ); bf16* CAT = (bf16*)(p->ws + WS_CAT); float* AGG = (float*)(p->ws + WS_AGG); bf16* LRS = (bf16*)(p->ws + WS_LRS);
    const int tid = tidx(), lane = tid & 63, w = tid >> 6, fr = lane & 15, fq = lane >> 4;
    const int blk = it % LRUB, ck = (it / LRUB) % LNT, b = it / (LRUB * LNT);
    const bool isctx = ck < LNC; const int cs = isctx ? ck : ck - LNC;
    const int seglen = isctx ? CTX : SEQ; const int segrow0 = isctx ? TL + b * CTX : b * SEQ; const int t0 = cs * LCH;
    if (pass == 2) {
        float* CAR = (float*)smem;
        half_sync(smem);
        if (tid < 128) { const int d = tid >> 6, gc = blk * 64 + (tid & 63); CAR[tid] = ((const float*)(p->ws + WS_CARRY))[((size_t)(b * LNT + ck) * 2 + d) * 512 + gc]; }
        const int r = tid >> 3, c8 = (tid & 7) * 8; const size_t row = (size_t)(segrow0 + t0 + r); const size_t lo = row * 512 + blk * 64 + c8;
        u32x4 hf = *(const u32x4*)(LRS + (size_t)0 * TT * 512 + lo), pf = *(const u32x4*)(LRS + (size_t)1 * TT * 512 + lo), hr = *(const u32x4*)(LRS + (size_t)2 * TT * 512 + lo), pr = *(const u32x4*)(LRS + (size_t)3 * TT * 512 + lo);
        u32x4 gg = *(const u32x4*)(PROJ + row * LDP + blk * 64 + c8);
        half_sync(smem);
        const unsigned hfa[4] = {hf.x, hf.y, hf.z, hf.w}, pfa[4] = {pf.x, pf.y, pf.z, pf.w}, hra[4] = {hr.x, hr.y, hr.z, hr.w}, pra[4] = {pr.x, pr.y, pr.z, pr.w}, gga[4] = {gg.x, gg.y, gg.z, gg.w};
        u32x4 o; unsigned oo[4];
#pragma unroll
        for (int q = 0; q < 4; ++q) { const float cf0 = CAR[c8 + 2 * q], cf1 = CAR[c8 + 2 * q + 1], cr0 = CAR[64 + c8 + 2 * q], cr1 = CAR[64 + c8 + 2 * q + 1];
            const float v0 = (bflo(hfa[q]) + bflo(pfa[q]) * cf0 + bflo(hra[q]) + bflo(pra[q]) * cr0) * bflo(gga[q]);
            const float v1 = (bfhi(hfa[q]) + bfhi(pfa[q]) * cf1 + bfhi(hra[q]) + bfhi(pra[q]) * cr1) * bfhi(gga[q]);
            oo[q] = pk2(v0, v1); }
        o.x = oo[0]; o.y = oo[1]; o.z = oo[2]; o.w = oo[3];
        *(u32x4*)(CAT + row * LDC + blk * 64 + c8) = o;
        return;
    }
    bf16* XA = (bf16*)smem;
    constexpr int LS = 68;
    float* U = (float*)(smem + 4608);
    float* A_ = (float*)(smem + 4608 + LCH * LS * 4);
    float* BX = A_ + 2 * LCH * LS;
    half_sync(smem);
    if (W.blk != blk) { W.blk = blk;
        const int gcc = blk * 64 + (tid & 63);
        W.cbv = p->in[I_ab_conv_b][gcc];
#pragma unroll
        for (int j = 0; j < 4; ++j) W.cwv[j] = p->in[I_ab_conv_w][j * LRUW + gcc];
#pragma unroll
        for (int d = 0; d < 2; ++d) { const bf16* WR = (const bf16*)(p->ws + WS_WLR) + (size_t)((d * LRUB + blk) * 2) * 4096 + (w * 16 + fr) * 64 + fq * 8;
#pragma unroll
            for (int ks = 0; ks < 2; ++ks) { W.wfr[d][0][ks] = *(const bf16x8*)(WR + ks * 32); W.wfr[d][1][ks] = *(const bf16x8*)(WR + 4096 + ks * 32); }
            const int gc4 = d * LRUW + blk * 64 + w * 16 + fq * 4;
            W.cbr[d] = *(const f32x4*)(p->in[I_ab_b_r] + gc4); W.cbi[d] = *(const f32x4*)(p->in[I_ab_b_i] + gc4); W.csp[d] = *(const f32x4*)((const float*)(p->ws + WS_LSP) + gc4); } }
    const float cbv = W.cbv; float cwv[4];
#pragma unroll
    for (int j = 0; j < 4; ++j) cwv[j] = W.cwv[j];
#pragma unroll
    for (int k = 0; k < 2; ++k) { const int i = tid + k * 256; if (i < (LCH + 3) * 8) *(u32x4*)(XA + (i >> 3) * 64 + (i & 7) * 8) = xav[k]; }
    if (it_next >= 0) lru_xa_request(p, it_next, xav);
    half_sync(smem);
    for (int i = tid; i < LCH * 64; i += 256) { const int r = i >> 6, ch = i & 63; float a = cbv;
#pragma unroll
        for (int j = 0; j < 4; ++j) a += cwv[j] * bf2f(XA[(r + j) * 64 + ch]);
        U[r * LS + ch] = a; }
    half_sync(smem);
#pragma unroll
    for (int d = 0; d < 2; ++d) {
        f32x4 ar[2], ai[2];
#pragma unroll
        for (int tf = 0; tf < 2; ++tf) { ar[tf] = (f32x4){0.f, 0.f, 0.f, 0.f}; ai[tf] = (f32x4){0.f, 0.f, 0.f, 0.f}; }
#pragma unroll
        for (int ks = 0; ks < 2; ++ks)
#pragma unroll
            for (int tf = 0; tf < 2; ++tf) { const float* up = U + (tf * 16 + fr) * LS + ks * 32 + fq * 8; f32x4 u0 = *(const f32x4*)up, u1 = *(const f32x4*)(up + 4);
                bf16x8 uf = pack8(u0[0], u0[1], u0[2], u0[3], u1[0], u1[1], u1[2], u1[3]);
                ar[tf] = MFMA16(W.wfr[d][0][ks], uf, ar[tf]); ai[tf] = MFMA16(W.wfr[d][1][ks], uf, ai[tf]); }
#pragma unroll
        for (int tf = 0; tf < 2; ++tf)
#pragma unroll
            for (int j = 0; j < 4; ++j) { const int tok = tf * 16 + fr, ch = w * 16 + fq * 4 + j;
                const float r = sigmoidf_(ar[tf][j] + W.cbr[d][j]), ig = sigmoidf_(ai[tf][j] + W.cbi[d][j]);
                const float a = exp2f_(-11.541560327111707f * r * W.csp[d][j]);
                const float bx = sqrtf_(fmaxf(1.0f - a * a, 0.f)) * ig * U[tok * LS + ch];
                A_[(d * LCH + tok) * LS + ch] = a; BX[(d * LCH + tok) * LS + ch] = bx; }
    }
    half_sync(smem);
    if (tid < 128) { const int d = tid >> 6, ch = tid & 63, gc = blk * 64 + ch;
        float av[LCH], bv[LCH];
#pragma unroll
        for (int i = 0; i < LCH; ++i) { const int tok = d ? LCH - 1 - i : i; av[i] = A_[(d * LCH + tok) * LS + ch]; bv[i] = BX[(d * LCH + tok) * LS + ch]; }
        float h = 0.f, ap = 1.f;
#pragma unroll
        for (int i = 0; i < LCH; ++i) { const int tok = d ? LCH - 1 - i : i; h = av[i] * h + bv[i]; ap *= av[i]; A_[(d * LCH + tok) * LS + ch] = h; BX[(d * LCH + tok) * LS + ch] = ap; }
        float* ag = AGG + ((size_t)(b * LNT + ck) * 2 + d) * 1024; ag[gc] = ap; ag[512 + gc] = h;
    }
    half_sync(smem);
    for (int i = tid; i < 4 * LCH * 8; i += 256) { const int arr = i / (LCH * 8), rem = i % (LCH * 8), tok = rem >> 3, c8 = (rem & 7) * 8; const int d = arr >> 1;
        const float* src = ((arr & 1) ? BX : A_) + (d * LCH + tok) * LS + c8; f32x4 v0 = *(const f32x4*)src, v1 = *(const f32x4*)(src + 4);
        u32x4 o; o.x = pk2(v0[0], v0[1]); o.y = pk2(v0[2], v0[3]); o.z = pk2(v1[0], v1[1]); o.w = pk2(v1[2], v1[3]);
        *(u32x4*)(LRS + (size_t)arr * TT * 512 + (size_t)(segrow0 + t0 + tok) * 512 + blk * 64 + c8) = o; }
}

constexpr int HSTR = DM + 8;
DEV unsigned f2key(float f) { unsigned u = __builtin_bit_cast(unsigned, f); return (u & 0x80000000u) ? ~u : (u | 0x80000000u); }
DEV float grpmax(float v) {
#pragma unroll
    for (int d = 1; d < PER; d <<= 1) v = fmaxf(v, __shfl_xor(v, d));
    return v;
}
template <int TPW> DEV void router_item(KP p, char* smem, int it, int l, int ntok) {
    constexpr int NTOK = 4 * TPW; static_assert(NTOK <= 32, "two token frags");
    const int tid = tidx(), lane = tid & 63, w = tid >> 6, fr = lane & 15, fq = lane >> 4;
    bf16* HH = (bf16*)smem;
    float* LG = (float*)smem;
    int* CL = (int*)(LG + 32 * 64); int* BASE = CL + 64; int* SELE = BASE + 64; int* SELP = SELE + 256; float* SELG = (float*)(SELP + 256);
    const bf16* X = (const bf16*)(p->ws + WS_X); unsigned char* H8 = (unsigned char*)(p->ws + WS_HA);
    unsigned* CNT = (unsigned*)(p->ws + WS_CTL) + CW_CNT + l * (NE + 1);
    const int t0 = it * NTOK;
    half_sync(smem);
    {
        const float* g = p->in[I_g_ffn] + l * DM;
        f32x4 gv[NV];
#pragma unroll
        for (int i = 0; i < NV; ++i) gv[i] = *(const f32x4*)(g + i * 256 + lane * 4);
        int cur_r = -1; f32x4 gs[NV], sv[NV];
        u32x2 xr[TPW][NV];
#pragma unroll
        for (int u = 0; u < TPW; ++u) { const int t = t0 + w * TPW + u, tc = t < ntok ? t : ntok - 1;
#pragma unroll
            for (int i = 0; i < NV; ++i) xr[u][i] = *(const u32x2*)(X + (size_t)tc * DM + i * 256 + lane * 4); }
#pragma unroll
        for (int u = 0; u < TPW; ++u) { const int tl = w * TPW + u, t = t0 + tl; const int tc = t < ntok ? t : ntok - 1;
            f32x4 v[NV];
#pragma unroll
            for (int i = 0; i < NV; ++i) v[i] = (f32x4){bflo(xr[u][i].x), bfhi(xr[u][i].x), bflo(xr[u][i].y), bfhi(xr[u][i].y)};
            const float rstd = row_rstd(v);
            if (mod_row(tc) != cur_r) { cur_r = mod_row(tc); const float* sh = modp(p, l, tc, 3); const float* sc = modp(p, l, tc, 4);
#pragma unroll
                for (int i = 0; i < NV; ++i) { const int k = i * 256 + lane * 4; const f32x4 ss = *(const f32x4*)(sc + k); sv[i] = *(const f32x4*)(sh + k);
#pragma unroll
                    for (int j = 0; j < 4; ++j) gs[i][j] = gv[i][j] * (1.0f + ss[j]); } }
#pragma unroll
            for (int i = 0; i < NV; ++i) { const int k = i * 256 + lane * 4; f32x4 h;
#pragma unroll
                for (int j = 0; j < 4; ++j) h[j] = v[i][j] * rstd * gs[i][j] + sv[i][j];
                if (t < ntok) *(unsigned*)(H8 + (size_t)t * DM + k) = pk4_fp8(h[0], h[1], h[2], h[3]);
                st_bf16x4(HH + tl * HSTR + k, h[0], h[1], h[2], h[3]); } }
        if (NTOK < 32) { for (int i = tid; i < (32 - NTOK) * (DM / 8); i += 256) { const int r = NTOK + i / (DM / 8), c = (i % (DM / 8)) * 8; *(u32x4*)(HH + r * HSTR + c) = (u32x4){0u, 0u, 0u, 0u}; } }
    }
    half_sync(smem);
    f32x4 a0 = (f32x4){0.f, 0.f, 0.f, 0.f}, a1 = a0;
    if (w * 16 < NE) {
        const bf16* Whi = (const bf16*)(p->ws + WS_WRT) + (size_t)l * 2 * NE * DM + (size_t)(w * 16 + fr) * DM + fq * 8;
#pragma unroll 1
        for (int kb = 0; kb < DM / 32; kb += 8) { bf16x8 wh[8];
#pragma unroll
            for (int q = 0; q < 8; ++q) wh[q] = *(const bf16x8*)(Whi + (kb + q) * 32);
#pragma unroll
            for (int q = 0; q < 8; ++q) { bf16x8 h0 = *(const bf16x8*)(HH + fr * HSTR + (kb + q) * 32 + fq * 8), h1 = *(const bf16x8*)(HH + (16 + fr) * HSTR + (kb + q) * 32 + fq * 8);
                a0 = MFMA16(wh[q], h0, a0); a1 = MFMA16(wh[q], h1, a1); } }
    }
    half_sync(smem);
    if (w * 16 < NE) {
#pragma unroll
        for (int j = 0; j < 4; ++j) { LG[fr * 64 + w * 16 + fq * 4 + j] = a0[j]; LG[(16 + fr) * 64 + w * 16 + fq * 4 + j] = a1[j]; } }
    if (tid < 64) CL[tid] = 0;
    half_sync(smem);
    const int e = lane < NE ? lane : 0; const bool ev = lane < NE; const unsigned long long lt = (1ull << lane) - 1ull;
    const float bias = p->in[I_b_router][l * NE + e];
#pragma unroll 2
    for (int u = 0; u < TPW; ++u) { const int tl = w * TPW + u, t = t0 + tl;
        const float sc = sigmoidf_(LG[tl * 64 + e]); const float sel = ev ? sc + bias : -3e38f;
        const float m1 = grpmax(sel); const int g = lane / PER;
        const unsigned long long gmask = (PER == 8 ? 0xFFull : ((1ull << PER) - 1ull)) << (g * PER);
        const unsigned long long b1 = __ballot(sel == m1) & gmask; const int first = __ffsll((long long)b1) - 1;
        const float m2 = grpmax(lane == first ? -3e38f : sel);
        float gsc = ev ? m1 + m2 : -3e38f;
        int grk = 0;
#pragma unroll
        for (int d = 1; d < 8; ++d) { float o = __shfl_xor(gsc, (d * PER) & 63); int gj = g ^ d; if (PER * 8 == 64 || (lane ^ (d * PER)) < NE) grk += (o > gsc || (o == gsc && gj < g)) ? 1 : 0; }
        const unsigned key = (ev && grk < 4) ? f2key(sel) : 0u;
        unsigned T = 0u;
#pragma unroll 1
        for (int bit = 31; bit >= 0; --bit) { const unsigned cand = T | (1u << bit); if (__popcll(__ballot(key >= cand)) >= 8) T = cand; }
        const bool gt = key > T; const int need = 8 - __popcll(__ballot(gt)); const unsigned long long eqb = __ballot(key == T);
        const bool chosen = gt || (key == T && __popcll(eqb & lt) < need);
        const int slot = __popcll(__ballot(chosen) & lt);
        const float gsum = wave_sum(chosen ? sc : 0.f);
        if (chosen) { SELE[tl * 8 + slot] = lane; SELG[tl * 8 + slot] = sc / gsum * 2.5f; SELP[tl * 8 + slot] = t < ntok ? atomicAdd(&CL[lane], 1) : 0; }
    }
    half_sync(smem);
    if (tid < NE) { const int c = CL[tid]; BASE[tid] = c > 0 ? (int)atomicAdd(&CNT[tid], (unsigned)c) : 0; }
    half_sync(smem);
    if (tid < NTOK * 8) { const int tl = tid >> 3, t = t0 + tl; if (t < ntok) { const int ee = SELE[tid]; const unsigned pos = (unsigned)(BASE[ee] + SELP[tid]);
        ((int*)(p->ws + WS_LIST))[(size_t)ee * TT + pos] = t; ((float*)(p->ws + WS_LISTW))[(size_t)ee * TT + pos] = SELG[tid];
        ((int*)(p->ws + WS_REF))[(size_t)t * 8 + (tid & 7)] = (int)((pos << 8) | (unsigned)ee); } }
}

constexpr int MOE_TAB = 131072;
constexpr int MOE_MAXTILES = 2560;
static_assert((TT * 9 + 255) / 256 + NE + 1 <= MOE_MAXTILES && MOE_TAB + 640 + MOE_MAXTILES * 4 <= BAR_ST_OFF, "MoE tile table fits in LDS");
DEV void moe_prefix(KP p, char* smem0, int l, int ntok) {
    int* TOFF = (int*)(smem0 + MOE_TAB); int* SOFF = TOFF + 80; unsigned* TILE = (unsigned*)(TOFF + 160);
    const unsigned* CNT = (const unsigned*)(p->ws + WS_CTL) + CW_CNT + l * (NE + 1);
    __syncthreads();
    if (tid512() < 64) {
        const int e = tid512(); const int c = e < NE ? (int)CNT[e] : 0; const int tl = (c + 255) / 256;
        int ts = tl, ss = c;
#pragma unroll
        for (int o = 1; o < 64; o <<= 1) { const int t2 = __shfl_up(ts, o), s2 = __shfl_up(ss, o); if (e >= o) { ts += t2; ss += s2; } }
        if (e < NE) { TOFF[e] = ts - tl; SOFF[e] = ss - c; }
        const int tt = __shfl(ts, 63), st = __shfl(ss, 63);
        if (e == 0) { TOFF[NE] = tt; SOFF[NE] = st; TOFF[NE + 1] = tt + (ntok + 255) / 256; SOFF[NE + 1] = st + ntok; } }
    __syncthreads();
    { const int e = tid512(); if (e <= NE) { const int t0 = TOFF[e], t1 = TOFF[e + 1]; for (int t = t0; t < t1; ++t) TILE[t] = ((unsigned)e << 16) | (unsigned)(t - t0); } }
    __syncthreads();
}
DEV void moe_find(const int* TOFF, int tile, int& e, int& mt) { const unsigned v = ((const unsigned*)(TOFF + 160))[tile]; e = (int)(v >> 16); mt = (int)(v & 0xffffu); }
struct JobG1 { KP p; const int* TOFF; const int* SOFF; const unsigned* CNT; int l, ntok;
    DEV void find(int it, int& e, int& mt, int& nt, int& nvalid) const { constexpr int NNT = 2 * DE / 256; const int tile = it / NNT; nt = it % NNT; moe_find(TOFF, tile, e, mt);
        const int cnt = e < NE ? (int)CNT[e] : ntok; nvalid = cnt - mt * 256 < 256 ? cnt - mt * 256 : 256; }
    DEV void setup(int it, GemmA8& a, GemmB8& b) const { int e, mt, nt, nvalid; find(it, e, mt, nt, nvalid);
        a = GemmA8{(const unsigned char*)(p->ws + WS_HA), DM, e < NE ? (const int*)(p->ws + WS_LIST) + (size_t)e * TT + mt * 256 : nullptr, mt * 256, nvalid};
        b = GemmB8{(const unsigned char*)(p->ws + WS_WGU) + ((size_t)e * 2 * DE + nt * 256) * DM, DM}; }
    DEV void epilogue(int it, f32x4 (&acc)[8][4], int rl0, int wc, int fq4) const { int e, mt, nt, nvalid; find(it, e, mt, nt, nvalid);
        EpiG1 epi{(unsigned char*)(p->ws + WS_ACT), SOFF[e] + mt * 256, nvalid, nt * 128 + wc * 32}; epi(acc, rl0, fq4); }
};
DEV void moe_g1_phase(KP p, char* smem0, int l, int ntok) {
    moe_prefix(p, smem0, l, ntok);
    const int* TOFF = (const int*)(smem0 + MOE_TAB);
    JobG1 job{p, TOFF, TOFF + 80, (const unsigned*)(p->ws + WS_CTL) + CW_CNT + l * (NE + 1), l, ntok};
    const int ntiles = TOFF[NE + 1] * (2 * DE / 256);
    gemm512_f8_stream<JobG1, true>(smem0, job, ntiles, DM);
    if (l == 0) {
        const int G = gridDim.x, extra = ntiles % G, vb = vblock(); const int nlight = G - extra; char* smem = smem0 + half_id() * HALF_LDS;
        if (nlight * 2 >= G) { if (vb >= extra) { for (int it = (vb - extra) * 2 + half_id(); it < CVM_DN; it += nlight * 2) conv_moe_item(p, smem, 0, CVM_GU + it); } }
        else { FOR_ITEMS(it, CVM_DN) conv_moe_item(p, smem, 0, CVM_GU + it); }
    }
}
struct JobG2 { KP p; const int* TOFF; const int* SOFF; const unsigned* CNT; int l, ntok;
    DEV void find(int it, int& e, int& mt, int& nt, int& nvalid) const { constexpr int NNT = DM / 256; const int tile = it / NNT; nt = it % NNT; moe_find(TOFF, tile, e, mt);
        const int cnt = e < NE ? (int)CNT[e] : ntok; nvalid = cnt - mt * 256 < 256 ? cnt - mt * 256 : 256; }
    DEV void setup(int it, GemmA8& a, GemmB8& b) const { int e, mt, nt, nvalid; find(it, e, mt, nt, nvalid);
        a = GemmA8{(const unsigned char*)(p->ws + WS_ACT), DE, nullptr, SOFF[e] + mt * 256, nvalid};
        b = GemmB8{(const unsigned char*)(p->ws + WS_WDN) + ((size_t)e * DM + nt * 256) * DE, DE}; }
    DEV void epilogue(int it, f32x4 (&acc)[8][4], int rl0, int wc, int fq4) const { int e, mt, nt, nvalid; find(it, e, mt, nt, nvalid);
        EpiG2 epi{(unsigned char*)(p->ws + WS_Y), SOFF[e] + mt * 256, nvalid, nt * 256 + wc * 64, e < NE ? (const float*)(p->ws + WS_LISTW) + (size_t)e * TT + mt * 256 : nullptr}; epi(acc, rl0, fq4); }
};
static_assert(DE % 128 == 0 && DM % 128 == 0, "fp8 GEMM K-steps of 128");
DEV void moe_g2_phase(KP p, char* smem0, int l, int ntok) {
    const int* TOFF = (const int*)(smem0 + MOE_TAB);
    JobG2 job{p, TOFF, TOFF + 80, (const unsigned*)(p->ws + WS_CTL) + CW_CNT + l * (NE + 1), l, ntok};
    gemm512_f8_stream<JobG2, false>(smem0, job, TOFF[NE + 1] * (DM / 256), DE);
}
constexpr int CPL = DM / 64, CV = CPL / 4;
static_assert(CPL == 16 || CPL == 4, "combine column mapping");
DEV void combine_phase(KP p, char* smem0, int l, int ntok) {
    const int* SOFF = (const int*)(smem0 + MOE_TAB) + 80;
    const int lane = tidx() & 63, c0 = lane * CPL; bf16* X = (bf16*)(p->ws + WS_X); const unsigned char* Y = (const unsigned char*)(p->ws + WS_Y); const int* REF = (const int*)(p->ws + WS_REF);
    const int gw = ((int)blockIdx.x * 2 + half_id()) * 4 + (tidx() >> 6), nwv = (int)gridDim.x * 8, per = (ntok + nwv - 1) / nwv;
    const int tbeg = gw * per, tend = tbeg + per < ntok ? tbeg + per : ntok;
    int cur_r = -1; f32x4 g2v[CV], gsv[CV], shv[CV];
#pragma unroll
    for (int i = 0; i < CV; ++i) { g2v[i] = (f32x4){0.f, 0.f, 0.f, 0.f}; shv[i] = g2v[i]; gsv[i] = l == 0 ? g2v[i] : *(const f32x4*)(p->in[I_g_final] + c0 + 4 * i); }
#pragma unroll 1
    for (int t = tbeg; t < tend; ++t) {
        if (mod_row(t) != cur_r) { cur_r = mod_row(t); const float* g2 = modp(p, l, t, 5);
#pragma unroll
            for (int i = 0; i < CV; ++i) g2v[i] = *(const f32x4*)(g2 + c0 + 4 * i) * (1.0f / Y8_SCALE);
            if (l == 0) { const float* gm = p->in[I_g_mix] + DM; const float* sh = modp(p, 1, t, 0); const float* sc = modp(p, 1, t, 1);
#pragma unroll
                for (int i = 0; i < CV; ++i) { const f32x4 gg = *(const f32x4*)(gm + c0 + 4 * i), c4 = *(const f32x4*)(sc + c0 + 4 * i); shv[i] = *(const f32x4*)(sh + c0 + 4 * i);
#pragma unroll
                    for (int j = 0; j < 4; ++j) gsv[i][j] = gg[j] * (1.0f + c4[j]); } } }
        f32x4 acc[CV];
#pragma unroll
        for (int i = 0; i < CV; ++i) acc[i] = (f32x4){0.f, 0.f, 0.f, 0.f};
#pragma unroll
        for (int k = 0; k < 9; ++k) { int slot; if (k < 8) { int r = REF[(size_t)t * 8 + k]; slot = SOFF[r & 255] + (int)((unsigned)r >> 8); } else slot = SOFF[NE] + t;
            const unsigned char* yr = Y + (size_t)slot * DM + c0;
            unsigned wv[CV];
            if (CV == 4) { u32x4 u = *(const u32x4*)yr; wv[0] = u.x; wv[1 % CV] = u.y; wv[2 % CV] = u.z; wv[3 % CV] = u.w; } else wv[0] = *(const unsigned*)yr;
#pragma unroll
            for (int i = 0; i < CV; ++i) acc[i] = acc[i] + un4_fp8(wv[i]); }
        f32x4 v[CV]; float ss = 0.f;
#pragma unroll
        for (int i = 0; i < CV; ++i) { u32x2 xu = *(const u32x2*)(X + (size_t)t * DM + c0 + 4 * i);
            v[i] = (f32x4){bflo(xu.x), bfhi(xu.x), bflo(xu.y), bfhi(xu.y)} + g2v[i] * acc[i];
            ss += v[i][0] * v[i][0] + v[i][1] * v[i][1] + v[i][2] * v[i][2] + v[i][3] * v[i][3]; }
        ss = wave_sum(ss); const float rstd = rsqrtf(ss * (1.0f / DM) + EPS);
        if (l == 0) {
            bf16* hb = (bf16*)(p->ws + WS_HB) + (size_t)t * DM + c0;
#pragma unroll
            for (int i = 0; i < CV; ++i) { st_bf16x4(X + (size_t)t * DM + c0 + 4 * i, v[i][0], v[i][1], v[i][2], v[i][3]);
                f32x4 h;
#pragma unroll
                for (int j = 0; j < 4; ++j) h[j] = v[i][j] * rstd * gsv[i][j] + shv[i][j];
                st_bf16x4(hb + 4 * i, h[0], h[1], h[2], h[3]); }
        } else {
#pragma unroll
            for (int i = 0; i < CV; ++i) *(f32x4*)(p->out + (size_t)t * DM + c0 + 4 * i) = v[i] * rstd * gsv[i];
        }
    }
}

constexpr int CONV_ITEMS = TT / 32;
DEV void ssdconv_item(KP p, int it) {
    const bf16* PROJ = (const bf16*)(p->ws + WS_PROJ); bf16* U = (bf16*)(p->ws + WS_U); float* DTV = (float*)(p->ws + WS_DTV);
    const int tid = tidx(); const int row0 = it * 32; const bool lat = row0 < TL;
    const int seglen = lat ? SEQ : CTX; const int segrow0 = lat ? (row0 / SEQ) * SEQ : TL + ((row0 - TL) / CTX) * CTX; const int t0 = row0 - segrow0;
    const int c4 = tid * 4; f32x4 w[4], bb = *(const f32x4*)(p->in[I_cd_conv_b] + c4);
#pragma unroll
    for (int j = 0; j < 4; ++j) w[j] = *(const f32x4*)(p->in[I_cd_conv_w] + j * 1024 + c4);
    u32x2 rw[35];
#pragma unroll
    for (int r = 0; r < 35; ++r) { const int t = t0 - 1 + r; rw[r] = (u32x2){0u, 0u}; if (t >= 0 && t < seglen) rw[r] = *(const u32x2*)(PROJ + (size_t)(segrow0 + t) * LDP + 2048 + c4); }
    f32x4 win[4];
    win[0] = (f32x4){bflo(rw[0].x), bfhi(rw[0].x), bflo(rw[0].y), bfhi(rw[0].y)}; win[1] = (f32x4){bflo(rw[1].x), bfhi(rw[1].x), bflo(rw[1].y), bfhi(rw[1].y)}; win[2] = (f32x4){bflo(rw[2].x), bfhi(rw[2].x), bflo(rw[2].y), bfhi(rw[2].y)};
#pragma unroll
    for (int r = 0; r < 32; ++r) { win[3] = (f32x4){bflo(rw[r + 3].x), bfhi(rw[r + 3].x), bflo(rw[r + 3].y), bfhi(rw[r + 3].y)};
        f32x4 a = bb + w[0] * win[0] + w[1] * win[1] + w[2] * win[2] + w[3] * win[3];
        st_bf16x4(U + (size_t)(row0 + r) * 1024 + c4, siluf_(a[0]), siluf_(a[1]), siluf_(a[2]), siluf_(a[3]));
        win[0] = win[1]; win[1] = win[2]; win[2] = win[3]; }
    for (int i = tid; i < 32 * 16; i += 256) { int r = i >> 4, c = i & 15; float raw = bf2f(PROJ[(size_t)(row0 + r) * LDP + 3072 + c]);
        DTV[(size_t)(row0 + r) * 16 + c] = softplusf_(raw + p->in[I_cd_dt_bias][c]); }
}
DEV int ssd_chunk_row0(int b, int c) { return c < NCC ? TL + b * CTX + c * 128 : b * SEQ + (c - NCC) * 128; }
constexpr int TSTR = 136;
constexpr int SSD1_ITEMS = NB * NCH * 8;
DEV void ssd1_item(KP p, char* smem, int it) {
    const bf16* U = (const bf16*)(p->ws + WS_U); const float* DTV = (const float*)(p->ws + WS_DTV);
    const int tid = tidx(), lane = tid & 63, w = tid >> 6, fr = lane & 15, fq = lane >> 4;
    const int h = it % 8, c = (it / 8) % NCH, b = it / (8 * NCH), g = h / 4; const int row0 = ssd_chunk_row0(b, c);
    bf16* XT = (bf16*)smem;
    bf16* BT = XT + 2 * 64 * TSTR;
    float* WGT = (float*)(BT + 128 * TSTR);
    half_sync(smem);
    if (tid < 128) { const int d = tid >> 6;
        const float a = -__expf(p->in[I_cd_a_log][d * 8 + h]); const int l0 = lane * 2;
        float dt0 = DTV[(size_t)(row0 + l0) * 16 + d * 8 + h], dt1 = DTV[(size_t)(row0 + l0 + 1) * 16 + d * 8 + h];
        float s = (dt0 + dt1) * a, incl = s;
#pragma unroll
        for (int o = 1; o < 64; o <<= 1) { float v = __shfl_up(incl, o); if (lane >= o) incl += v; }
        const float total = __shfl(incl, 63); const float ex = incl - s;
        if (d == 0) { WGT[l0] = __expf(total - (ex + dt0 * a)) * dt0; WGT[l0 + 1] = __expf(total - incl) * dt1; }
        else { WGT[128 + l0] = __expf(ex) * dt0; WGT[128 + l0 + 1] = __expf(ex + dt0 * a) * dt1; }
        if (lane == 0) ((float*)(p->ws + WS_DEC))[((size_t)(b * NCH + c) * 2 + d) * 8 + h] = __expf(total);
    }
    half_sync(smem);
    for (int i = tid; i < 64 * 8; i += 256) { const int l = (i >> 3) * 2, part = i & 7; const bf16* up = U + (size_t)(row0 + l) * 1024 + h * 64 + part * 8; u32x4 v0 = *(const u32x4*)up, v1 = *(const u32x4*)(up + 1024);
        const float wf0 = WGT[l], wf1 = WGT[l + 1], wv0 = WGT[128 + l], wv1 = WGT[128 + l + 1];
        const unsigned u0[4] = {v0.x, v0.y, v0.z, v0.w}, u1[4] = {v1.x, v1.y, v1.z, v1.w};
#pragma unroll
        for (int j = 0; j < 8; ++j) { const float x0 = (j & 1) ? bfhi(u0[j >> 1]) : bflo(u0[j >> 1]), x1 = (j & 1) ? bfhi(u1[j >> 1]) : bflo(u1[j >> 1]); const int pp = part * 8 + j;
            *(unsigned*)(XT + (0 * 64 + pp) * TSTR + l) = pk2(x0 * wf0, x1 * wf1); *(unsigned*)(XT + (1 * 64 + pp) * TSTR + l) = pk2(x0 * wv0, x1 * wv1); } }
    for (int i = tid; i < 64 * 16; i += 256) { const int l = (i >> 4) * 2, part = i & 15; const bf16* up = U + (size_t)(row0 + l) * 1024 + 512 + g * 128 + part * 8; u32x4 v0 = *(const u32x4*)up, v1 = *(const u32x4*)(up + 1024);
        const unsigned u0[4] = {v0.x, v0.y, v0.z, v0.w}, u1[4] = {v1.x, v1.y, v1.z, v1.w};
#pragma unroll
        for (int j = 0; j < 8; ++j) { const unsigned a = (j & 1) ? (u0[j >> 1] >> 16) : (u0[j >> 1] & 0xffffu), c = (j & 1) ? (u1[j >> 1] >> 16) : (u1[j >> 1] & 0xffffu);
            *(unsigned*)(BT + (part * 8 + j) * TSTR + l) = a | (c << 16); } }
    half_sync(smem);
    float* ST = (float*)(p->ws + WS_ST);
#pragma unroll 1
    for (int d = 0; d < 2; ++d) {
        f32x4 acc[8];
#pragma unroll
        for (int nf = 0; nf < 8; ++nf) acc[nf] = (f32x4){0.f, 0.f, 0.f, 0.f};
#pragma unroll
        for (int ks = 0; ks < 4; ++ks) { bf16x8 xa = *(const bf16x8*)(XT + (d * 64 + w * 16 + fr) * TSTR + ks * 32 + fq * 8);
#pragma unroll
            for (int nf = 0; nf < 8; ++nf) { bf16x8 bfm = *(const bf16x8*)(BT + (nf * 16 + fr) * TSTR + ks * 32 + fq * 8); acc[nf] = MFMA16(bfm, xa, acc[nf]); } }
        float* st = ST + (((size_t)(b * NCH + c) * 2 + d) * 8 + h) * 8192 + (w * 16 + fr) * 128 + fq * 4;
#pragma unroll
        for (int nf = 0; nf < 8; ++nf) *(f32x4*)(st + nf * 16) = acc[nf];
    }
}
constexpr int SSD2_ITEMS = NB * 2 * 8 * 4;
DEV void ssd2_item(KP p, int it) {
    const float* ST = (const float*)(p->ws + WS_ST); const float* DEC = (const float*)(p->ws + WS_DEC); bf16* HIN = (bf16*)(p->ws + WS_HIN);
    const int q = it & 3, h = (it >> 2) & 7, d = (it >> 5) & 1, b = it >> 6; const int e0 = q * 2048 + tidx() * 8;
    f32x4 c0 = (f32x4){0.f, 0.f, 0.f, 0.f}, c1 = c0;
    constexpr int SB = 6;
    for (int i0 = 0; i0 < NCH; i0 += SB) { f32x4 s0[SB], s1[SB]; float dec[SB]; int cc[SB];
#pragma unroll
        for (int j = 0; j < SB; ++j) { const int i = i0 + j < NCH ? i0 + j : NCH - 1; const int c = d == 0 ? i : (i < NCC ? NCC - 1 - i : NCH - 1 - (i - NCC)); cc[j] = c;
            const float* st = ST + (((size_t)(b * NCH + c) * 2 + d) * 8 + h) * 8192 + e0; dec[j] = DEC[((size_t)(b * NCH + c) * 2 + d) * 8 + h];
            s0[j] = *(const f32x4*)st; s1[j] = *(const f32x4*)(st + 4); }
#pragma unroll
        for (int j = 0; j < SB; ++j) if (i0 + j < NCH) { const int c = cc[j];
            if (c >= NCC) { u32x4 o; o.x = pk2(c0[0], c0[1]); o.y = pk2(c0[2], c0[3]); o.z = pk2(c1[0], c1[1]); o.w = pk2(c1[2], c1[3]);
                *(u32x4*)(HIN + (((size_t)(b * NCL + c - NCC) * 2 + d) * 8 + h) * 8192 + e0) = o; }
            c0 = c0 * dec[j] + s0[j]; c1 = c1 * dec[j] + s1[j]; } }
}
constexpr int SSD3_ITEMS = NB * NCL * 4;
DEV void ssd3_item(KP p, char* smem, int it) {
    const bf16* U = (const bf16*)(p->ws + WS_U); const float* DTV = (const float*)(p->ws + WS_DTV); const bf16* PROJ = (const bf16*)(p->ws + WS_PROJ); bf16* CAT = (bf16*)(p->ws + WS_CAT);
    const float* ST = (const float*)(p->ws + WS_ST);
    const int tid = tidx(), lane = tid & 63, w = tid >> 6, fr = lane & 15, fq = lane >> 4;
    const int hf = it & 1, g = (it >> 1) & 1, cl = (it >> 2) % NCL, b = it / (4 * NCL); const int c = NCC + cl; const int row0 = b * SEQ + cl * 128;
    const int LF = hf * 4 + w; const int l = LF * 16 + fr;
    bf16* CS = (bf16*)smem;
    bf16* R2 = CS + 128 * TSTR;
    bf16* XT = R2; bf16* HB = R2 + 64 * TSTR;
    float* AC = (float*)(R2 + 128 * TSTR);
    float* DT = AC + 256;
    half_sync(smem);
    for (int i = tid; i < 128 * 16; i += 256) { int ll = i >> 4, part = i & 15;
        *(u32x4*)(CS + ll * TSTR + part * 8) = *(const u32x4*)(U + (size_t)(row0 + ll) * 1024 + 768 + g * 128 + part * 8);
        *(u32x4*)(R2 + ll * TSTR + part * 8) = *(const u32x4*)(U + (size_t)(row0 + ll) * 1024 + 512 + g * 128 + part * 8); }
    half_sync(smem);
    f32x4 cbt[8];
#pragma unroll
    for (int sf = 0; sf < 8; ++sf) cbt[sf] = (f32x4){0.f, 0.f, 0.f, 0.f};
#pragma unroll
    for (int ks = 0; ks < 4; ++ks) { bf16x8 cf = *(const bf16x8*)(CS + l * TSTR + ks * 32 + fq * 8);
#pragma unroll
        for (int sf = 0; sf < 8; ++sf) { bf16x8 bfm = *(const bf16x8*)(R2 + (sf * 16 + fr) * TSTR + ks * 32 + fq * 8); cbt[sf] = MFMA16(bfm, cf, cbt[sf]); } }
    float ss = 0.f; const size_t row = (size_t)(row0 + l);
#pragma unroll 1
    for (int hh = 0; hh < 4; ++hh) {
        const int h = g * 4 + hh;
        u32x4 hbv[2][4]; u32x2 zv[4];
#pragma unroll
        for (int d = 0; d < 2; ++d) { const bf16* hin = (const bf16*)(p->ws + WS_HIN) + (((size_t)(b * NCL + cl) * 2 + d) * 8 + h) * 8192;
#pragma unroll
            for (int k = 0; k < 4; ++k) { const int i = tid + k * 256; hbv[d][k] = *(const u32x4*)(hin + (i >> 4) * 128 + (i & 15) * 8); } }
#pragma unroll
        for (int pf = 0; pf < 4; ++pf) zv[pf] = *(const u32x2*)(PROJ + row * LDP + 512 + h * 64 + pf * 16 + fq * 4);
        half_sync(smem);
        if (tid < 128) { const int d = tid >> 6; const float a = -__expf(p->in[I_cd_a_log][d * 8 + h]); const int l0 = lane * 2;
            float dt0 = DTV[(size_t)(row0 + l0) * 16 + d * 8 + h], dt1 = DTV[(size_t)(row0 + l0 + 1) * 16 + d * 8 + h];
            float s2 = (dt0 + dt1) * a, incl = s2;
#pragma unroll
            for (int o = 1; o < 64; o <<= 1) { float v = __shfl_up(incl, o); if (lane >= o) incl += v; }
            const float total = __shfl(incl, 63), ex = incl - s2;
            if (d == 0) { AC[l0] = ex + dt0 * a; AC[l0 + 1] = incl; } else { AC[128 + l0] = total - ex; AC[128 + l0 + 1] = total - ex - dt0 * a; }
            DT[d * 128 + l0] = dt0; DT[d * 128 + l0 + 1] = dt1; }
        for (int i = tid; i < 64 * 8; i += 256) { const int ll = (i >> 3) * 2, part = i & 7; const bf16* up = U + (size_t)(row0 + ll) * 1024 + h * 64 + part * 8; u32x4 v0 = *(const u32x4*)up, v1 = *(const u32x4*)(up + 1024);
            const unsigned u0[4] = {v0.x, v0.y, v0.z, v0.w}, u1[4] = {v1.x, v1.y, v1.z, v1.w};
#pragma unroll
            for (int j = 0; j < 8; ++j) { const unsigned a = (j & 1) ? (u0[j >> 1] >> 16) : (u0[j >> 1] & 0xffffu), c = (j & 1) ? (u1[j >> 1] >> 16) : (u1[j >> 1] & 0xffffu);
                *(unsigned*)(XT + (part * 8 + j) * TSTR + ll) = a | (c << 16); } }
        half_sync(smem);
        f32x4 y[4];
#pragma unroll
        for (int pf = 0; pf < 4; ++pf) y[pf] = (f32x4){0.f, 0.f, 0.f, 0.f};
#pragma unroll
        for (int k2 = 0; k2 < 4; ++k2) {
#pragma unroll 1
            for (int d = 0; d < 2; ++d) {
                const float acl = AC[d * 128 + l]; float wv[8];
#pragma unroll
                for (int jj = 0; jj < 8; ++jj) { const int s = (2 * k2 + (jj >> 2)) * 16 + fq * 4 + (jj & 3);
                    const bool ok = d == 0 ? s <= l : s >= l; const float arg = ok ? acl - AC[d * 128 + s] : -1e30f;
                    wv[jj] = cbt[2 * k2 + (jj >> 2)][jj & 3] * __expf(arg) * DT[d * 128 + s]; }
                bf16x8 wfr = pack8(wv[0], wv[1], wv[2], wv[3], wv[4], wv[5], wv[6], wv[7]);
#pragma unroll
                for (int pf = 0; pf < 4; ++pf) { u32x2 lo = *(const u32x2*)(XT + (pf * 16 + fr) * TSTR + k2 * 32 + fq * 4), hi = *(const u32x2*)(XT + (pf * 16 + fr) * TSTR + k2 * 32 + 16 + fq * 4);
                    u32x4 vv; vv.x = lo.x; vv.y = lo.y; vv.z = hi.x; vv.w = hi.y; bf16x8 xf = __builtin_bit_cast(bf16x8, vv);
                    y[pf] = MFMA16(xf, wfr, y[pf]); }
            }
        }
        { const float dsk = p->in[I_cd_d_skip][h];
#pragma unroll
          for (int pf = 0; pf < 4; ++pf)
#pragma unroll
              for (int j = 0; j < 4; ++j) y[pf][j] += dsk * bf2f(XT[(pf * 16 + fq * 4 + j) * TSTR + l]); }
#pragma unroll 1
        for (int d = 0; d < 2; ++d) {
            half_sync(smem);
#pragma unroll
            for (int k = 0; k < 4; ++k) { const int i = tid + k * 256; *(u32x4*)(HB + (i >> 4) * TSTR + (i & 15) * 8) = d ? hbv[1][k] : hbv[0][k]; }
            half_sync(smem);
            f32x4 tt[4];
#pragma unroll
            for (int pf = 0; pf < 4; ++pf) tt[pf] = (f32x4){0.f, 0.f, 0.f, 0.f};
#pragma unroll
            for (int ks = 0; ks < 4; ++ks) { bf16x8 cf = *(const bf16x8*)(CS + l * TSTR + ks * 32 + fq * 8);
#pragma unroll
                for (int pf = 0; pf < 4; ++pf) { bf16x8 hfm = *(const bf16x8*)(HB + (pf * 16 + fr) * TSTR + ks * 32 + fq * 8); tt[pf] = MFMA16(hfm, cf, tt[pf]); } }
            const float sc = __expf(AC[d * 128 + l]);
#pragma unroll
            for (int pf = 0; pf < 4; ++pf) y[pf] = y[pf] + tt[pf] * sc;
        }
#pragma unroll
        for (int pf = 0; pf < 4; ++pf) { u32x2 z = zv[pf];
            float v0 = y[pf][0] * siluf_(bflo(z.x)), v1 = y[pf][1] * siluf_(bfhi(z.x)), v2 = y[pf][2] * siluf_(bflo(z.y)), v3 = y[pf][3] * siluf_(bfhi(z.y));
            ss += v0 * v0 + v1 * v1 + v2 * v2 + v3 * v3; st_bf16x4(CAT + row * LDC + 512 + h * 64 + pf * 16 + fq * 4, v0, v1, v2, v3); }
    }
    ss += __shfl_xor(ss, 16); ss += __shfl_xor(ss, 32); const float rstd = rsqrtf(ss * (1.0f / 256.0f) + EPS);
#pragma unroll 1
    for (int hh = 0; hh < 4; ++hh)
#pragma unroll
        for (int pf = 0; pf < 4; ++pf) { const int ch = g * 256 + hh * 64 + pf * 16 + fq * 4; f32x4 ng = *(const f32x4*)(p->in[I_cd_norm_g] + ch); u32x2 pk = *(const u32x2*)(CAT + row * LDC + 512 + ch);
            st_bf16x4(CAT + row * LDC + 512 + ch, bflo(pk.x) * rstd * ng[0], bfhi(pk.x) * rstd * ng[1], bflo(pk.y) * rstd * ng[2], bfhi(pk.y) * rstd * ng[3]); }
}

#ifndef HIP_EMU
namespace cg = cooperative_groups;
#define XB_TMO      128
#define XB_XCNT(j)  (256  + 64 * (j))
#define XB_XSUB(j)  (1280 + 64 * (j))
#define XB_XGEN(j)  (2304 + 64 * (j))
#define XB_TOP      3328
#define XB_TOPGEN   3392
#define XCD_BAR_WORDS 3456
#define XB_SPIN_CAP (1u << 20)
DEV unsigned xb_ld(unsigned* p) { return __hip_atomic_load(p, __ATOMIC_RELAXED, __HIP_MEMORY_SCOPE_AGENT); }
DEV unsigned xb_add(unsigned* p, unsigned v) { return __hip_atomic_fetch_add(p, v, __ATOMIC_RELAXED, __HIP_MEMORY_SCOPE_AGENT); }
DEV unsigned xb_xcc_id() { return (unsigned)__builtin_amdgcn_s_getreg((3 << 11) | 20) & 0xFu; }
#define XB_SPIN(cond, bar) do { unsigned _sp = 0; while (cond) { __builtin_amdgcn_s_sleep(1); \
    if ((++_sp & 255u) == 0u) { if (xb_ld(&(bar)[XB_TMO])) break; if (_sp > XB_SPIN_CAP) { atomicAdd(&(bar)[XB_TMO], 1u); break; } } } } while (0)
struct XcdBarrier { unsigned* bar; unsigned x; unsigned* st; };
DEV void xcd_barrier_complete(unsigned* bar, unsigned x, unsigned& nloc, unsigned& nx) {
    const unsigned G = gridDim.x; unsigned sum, cnt, mine, sp = 0u;
    for (;;) { sum = 0u; cnt = 0u; mine = 0u;
#pragma unroll
        for (unsigned j = 0; j < 16; ++j) { const unsigned c = xb_ld(&bar[XB_XCNT(j)]); sum += c; cnt += (c > 0u) ? 1u : 0u; mine = (j == x) ? c : mine; }
        if (sum == G) break;
        __builtin_amdgcn_s_sleep(1);
        if ((++sp & 255u) == 0u) { if (xb_ld(&bar[XB_TMO])) break; if (sp > XB_SPIN_CAP) { atomicAdd(&bar[XB_TMO], 1u); break; } } }
    nloc = mine > 0u ? mine : 1u; nx = cnt > 0u ? cnt : 1u;
}
DEV void xcd_barrier(unsigned* st) {
    asm volatile("s_waitcnt vmcnt(0)" ::: "memory");
    __syncthreads();
    if (threadIdx.x == 0) {
        XcdBarrier b; b.bar = (unsigned*)(kparams()->ws + WS_CTL); b.x = xb_xcc_id(); b.st = st;
        unsigned* bar = b.bar;
        __builtin_amdgcn_s_waitcnt(0);
        unsigned nloc = b.st[0], nx = b.st[1];
        if (nloc == 0u) { xcd_barrier_complete(bar, b.x, nloc, nx); b.st[0] = nloc; b.st[1] = nx; }
        const unsigned old = xb_add(&bar[XB_XSUB(b.x)], 1u);
        const unsigned gen = old / nloc;
        if (old + 1u == (gen + 1u) * nloc) {
            __builtin_amdgcn_fence(__ATOMIC_RELEASE, "agent");
            asm volatile("s_waitcnt vmcnt(0)" ::: "memory");
            const unsigned og = xb_add(&bar[XB_TOP], 1u);
            const unsigned tg = og / nx;
            if (og + 1u == (tg + 1u) * nx) xb_add(&bar[XB_TOPGEN], 1u);
            else XB_SPIN(xb_ld(&bar[XB_TOPGEN]) == tg, bar);
            __builtin_amdgcn_fence(__ATOMIC_ACQUIRE, "agent");
            xb_add(&bar[XB_XGEN(b.x)], 1u);
            asm volatile("s_waitcnt vmcnt(0)" ::: "memory");
        } else {
            XB_SPIN(xb_ld(&bar[XB_XGEN(b.x)]) == gen, bar);
            __builtin_amdgcn_fence(__ATOMIC_ACQUIRE, "agent");
            asm volatile("s_waitcnt vmcnt(0)" ::: "memory");
        }
    }
    __syncthreads();
}
#endif

static_assert(MOD_ITEMS % 2 == 0 && (SEQ * 32 / 256) % 2 == 0 && WRT_ITEMS % 2 == 0 && WLR_ITEMS % 2 == 0 && CVP_ABIN % 2 == 0, "item-type boundaries must be even (lockstep halves)");
DEV void ph_prep(KP p, char* smem) {
    constexpr int N0 = MOD_ITEMS, N1 = N0 + SEQ * 32 / 256, N2 = N1 + WRT_ITEMS, N3 = N2 + 2, N4 = N3 + WLR_ITEMS, N5 = N4 + CVP_ABIN;
    FOR_ITEMS(it, N5) {
        if (it < N0) mod_item(p, smem, it); else if (it < N1) rope_item(p, it - N0); else if (it < N2) wrt_item(p, it - N1); else if (it < N3) lam_item(p); else if (it < N4) wlr_item(p, it - N3); else conv_proj_item(p, smem, it - N4); }
}
DEV void ph_norm0(KP p, char* smem) { (void)smem; norm0_range(p); }
struct JobIn0 { KP p;
    DEV void setup(int it, GemmA& a, GemmB& b) const { constexpr int NNT = AB_IN / 256; const int nt = it % NNT, mt = it / NNT;
        a = GemmA{(const bf16*)(p->ws + WS_HA), DM, nullptr, mt * 256, 256}; b = GemmB{(const bf16*)(p->ws + WS_WPROJ) + WP_ABIN + (size_t)nt * 256 * DM, DM}; }
    DEV void epilogue(int it, f32x4 (&acc)[8][4], int rl0, int wc, int fq4) const { constexpr int NNT = AB_IN / 256; const int nt = it % NNT, mt = it / NNT, nw0 = nt * 256 + wc * 64;
        const int ct = nw0 < 512 ? CT_GELU : nw0 < 1024 ? CT_ROPE_SCALE : nw0 < 1536 ? CT_RAW : nw0 < 1664 ? CT_ROPE : CT_VT;
        EpiProj epi{p, mt * 256, nw0, AB_IN, ct, 1664, 64, 2}; epi(acc, rl0, fq4); }
};
static_assert(AB_IN % 256 == 0 && TT % 256 == 0 && TL % 256 == 0 && DM % 256 == 0, "256-tiles");
DEV void ph_inproj0(KP p, char* smem0, char* smem) {
    JobIn0 job{p}; gemm512_stream8(smem0, job, (TT / 256) * (AB_IN / 256), DM);
}
static_assert((ATT0_LAT + ATT0_CTX) % 2 == 0 && LRU_ITEMS % 2 == 0, "even item-type boundaries");
DEV void ph_att0(KP p, char* smem) { FOR_ITEMS(it, ATT0_LAT + ATT0_CTX) att0_item(p, smem, it); }
DEV void ph_lru_carry(KP p, char* smem) { FOR_ITEMS(it, LRUC_ITEMS) lru_carry_item(p, it); }
DEV void ph_lru(KP p, char* smem, int pass) {
    const int nx = pass == 1 ? CVP_ITEMS - CVP_ABIN : 0;
    u32x4 xav[2] = {(u32x4){0u, 0u, 0u, 0u}, (u32x4){0u, 0u, 0u, 0u}}; LruW W; W.blk = -1;
    if (pass == 1) { const int it0 = (int)blockIdx.x * 2 + half_id(); if (it0 < LRU_ITEMS) lru_xa_request(p, it0, xav); }
    FOR_ITEMS(it, LRU_ITEMS + nx) {
        if (it < LRU_ITEMS) { const int nxt = it + (int)gridDim.x * 2; lru_item(p, smem, it, pass, xav, (pass == 1 && nxt < LRU_ITEMS) ? nxt : -1, W); }
        else conv_proj_item(p, smem, CVP_ABIN + it - LRU_ITEMS); } }
struct JobOut { KP p; int layer;
    DEV void setup(int it, GemmA& a, GemmB& b) const { constexpr int NNT = DM / 256; const int nt = it % NNT, mt = it / NNT;
        a = GemmA{(const bf16*)(p->ws + WS_CAT), LDC, nullptr, mt * 256, 256}; b = GemmB{(const bf16*)(p->ws + WS_WPROJ) + (layer == 0 ? WP_ABOUT : WP_CDOUT) + (size_t)nt * 256 * 1024, 1024}; }
    DEV void epilogue(int it, f32x4 (&acc)[8][4], int rl0, int wc, int fq4) const { constexpr int NNT = DM / 256; const int nt = it % NNT, mt = it / NNT;
        EpiOut epi{p, mt * 256, nt * 256 + wc * 64, layer}; epi(acc, rl0, fq4); }
};
DEV void ph_outproj(KP p, char* smem0, char* smem, int layer) {
    const int ntiles = (layer == 0 ? TT / 256 : TL / 256) * (DM / 256);
    JobOut job{p, layer}; gemm512_stream8(smem0, job, ntiles, 1024);
    const int G = gridDim.x, extra = ntiles % G, vb = vblock(); const int nlight = G - extra;
    if (vb >= extra) { for (int it = (vb - extra) * 2 + half_id(); it < CVM_GU; it += nlight * 2) conv_moe_item(p, smem, layer, it); }
}
static_assert(TT % 24 == 0 && TL % 32 == 0, "router item sizes");
DEV void ph_router(KP p, char* smem, int l) {
    if (l == 0) { FOR_ITEMS(it, TT / 24) { if (it_0 + half_id() < TT / 24) router_item<6>(p, smem, it, 0, TT); } }
    else { FOR_ITEMS(it, TL / 32) { if (it_0 + half_id() < TL / 32) router_item<8>(p, smem, it, 1, TL); } } }
struct JobIn1 { KP p;
    DEV void tile(int it, int& mt, int& nt) const { constexpr int NNT = (CD_IN + 255) / 256, MTL = TL / 256;
        if (it < MTL * NNT) { nt = it % NNT; mt = it / NNT; } else { int j = it - MTL * NNT; nt = 4 + j % (NNT - 4); mt = MTL + j / (NNT - 4); } }
    DEV void setup(int it, GemmA& a, GemmB& b) const { int mt, nt; tile(it, mt, nt);
        a = GemmA{(const bf16*)(p->ws + WS_HB), DM, nullptr, mt * 256, 256}; b = GemmB{(const bf16*)(p->ws + WS_WPROJ) + WP_CDIN + (size_t)nt * 256 * DM, DM}; }
    DEV void epilogue(int it, f32x4 (&acc)[8][4], int rl0, int wc, int fq4) const { int mt, nt; tile(it, mt, nt); const int nw0 = nt * 256 + wc * 64;
        const int ct = nw0 < 512 ? CT_ROPE_SCALE : nw0 < 1024 ? CT_RAW : nw0 < 1536 ? CT_ROPE : nw0 < 2048 ? CT_VT : CT_RAW;
        EpiProj epi{p, mt * 256, nw0, CD_IN, ct, 1536, 128, 4}; epi(acc, rl0, fq4); }
};
static_assert(TC % 256 == 0, "ctx rows in 256-tiles");
DEV void ph_inproj1(KP p, char* smem0, char* smem) {
    constexpr int NNT = (CD_IN + 255) / 256, MTL = TL / 256, MTC = TC / 256;
    const int ntiles = MTL * NNT + MTC * (NNT - 4);
    JobIn1 job{p}; gemm512_stream8(smem0, job, ntiles, DM);
    { const int G = gridDim.x, extra = ntiles % G, vb = vblock(), nl2 = (G - extra) * 2, nh2 = extra * 2; constexpr int CONV_SKEW = 11;
      if (extra == 0 || nl2 * CONV_SKEW >= CVM_DN) { FOR_ITEMS(it, CVM_DN) conv_moe_item(p, smem, 1, CVM_GU + it); }
      else { const int xh = (CVM_DN - nl2 * CONV_SKEW) / (nl2 + nh2); const int nlt = nl2 * (xh + CONV_SKEW);
          if (vb >= extra) { for (int it = (vb - extra) * 2 + half_id(); it < nlt; it += nl2) conv_moe_item(p, smem, 1, CVM_GU + it); }
          else { for (int it = nlt + vb * 2 + half_id(); it < CVM_DN; it += nh2) conv_moe_item(p, smem, 1, CVM_GU + it); } } }
}
static_assert(CONV_ITEMS % 2 == 0, "even item-type boundary");
DEV void ph_ssdconv(KP p, char* smem) { FOR_ITEMS(it, CONV_ITEMS) ssdconv_item(p, it); }
DEV void ph_att1(KP p, char* smem0) { __syncthreads(); for (int it = blockIdx.x; it < ATT1_N; it += gridDim.x) att1_item(p, smem0, it); __syncthreads(); }
DEV void ph_ssd1(KP p, char* smem) { FOR_ITEMS(it, SSD1_ITEMS) ssd1_item(p, smem, it); }
DEV void ph_ssd2(KP p, char* smem) { FOR_ITEMS(it, SSD2_ITEMS) ssd2_item(p, it); }
DEV void ph_ssd3(KP p, char* smem) { FOR_ITEMS(it, SSD3_ITEMS) ssd3_item(p, smem, it); }

#ifdef ONLY_PHASE
#define PH(k) ((k) == ONLY_PHASE)
#else
#define PH(k) true
#endif
#ifndef REP_MASK
#define REP_MASK 0u
#endif
#ifndef TS_MASK
#define TS_MASK 0u
#endif
#if !defined(HIP_EMU)
#define TSTAMP(k) do { if (TS_MASK != 0u && blockIdx.x == 0 && threadIdx.x == 0) { unsigned long long t_ = __builtin_amdgcn_s_memrealtime(); \
    if ((k) > 0 && ((TS_MASK >> ((k) - 1)) & 1u)) ts_acc += t_ - ts_prev; ts_prev = t_; } } while (0)
#else
#define TSTAMP(k) do {} while (0)
#endif
#define NREP(k) ((((unsigned)(REP_MASK) >> (k)) & 1u) ? 2 : 1)
#define RUN(k, call) do { for (int rep_ = 0; rep_ < NREP(k); ++rep_) { if (PH(k)) { call; } if (rep_ + 1 < NREP(k)) GRID_SYNC(); } } while (0)
__global__ void __launch_bounds__(512, 2) mega(Params p_arg) {
#ifdef HIP_EMU
    char* smem0 = emu_smem();
#define GRID_SYNC() emu_grid_sync()
#define GRID_SYNC0() emu_grid_sync()
#define KPARG (&p_arg)
#else
    __shared__ __attribute__((aligned(16))) char smem0[SMEM_BYTES];
    unsigned* bar_st = (unsigned*)(smem0 + BAR_ST_OFF);
    if (threadIdx.x < 8) bar_st[threadIdx.x] = 0u;
    __syncthreads();
    if (threadIdx.x == 0) (void)xb_add((unsigned*)(p_arg.ws + WS_CTL) + XB_XCNT(xb_xcc_id()), 1u);
#define GRID_SYNC() xcd_barrier(bar_st)
#define GRID_SYNC0() xcd_barrier(bar_st)
    if (p_arg.ws == nullptr) cg::this_grid().sync();
#define KPARG kparams()
#endif
    unsigned long long ts_prev = 0, ts_acc = 0; TSTAMP(0);
#define HSM (smem0 + half_id() * HALF_LDS)
    RUN(0, ph_prep(KPARG, HSM));              GRID_SYNC0(); TSTAMP(1);
    RUN(1, ph_norm0(KPARG, HSM));             GRID_SYNC(); TSTAMP(2);
    RUN(2, ph_inproj0(KPARG, smem0, HSM));    GRID_SYNC(); TSTAMP(3);
    RUN(3, ph_att0(KPARG, HSM));
    RUN(4, ph_lru(KPARG, HSM, 1));            GRID_SYNC(); TSTAMP(5);
    RUN(22, ph_lru_carry(KPARG, HSM));        GRID_SYNC();
    RUN(5, ph_lru(KPARG, HSM, 2));            GRID_SYNC(); TSTAMP(6);
    RUN(6, ph_outproj(KPARG, smem0, HSM, 0)); GRID_SYNC(); TSTAMP(7);
    RUN(7, ph_router(KPARG, HSM, 0));         GRID_SYNC(); TSTAMP(8);
    RUN(8, moe_g1_phase(KPARG, smem0, 0, TT)); GRID_SYNC(); TSTAMP(9);
    RUN(9, moe_g2_phase(KPARG, smem0, 0, TT)); GRID_SYNC(); TSTAMP(10);
    RUN(10, combine_phase(KPARG, smem0, 0, TT)); GRID_SYNC(); TSTAMP(11);
    RUN(11, ph_inproj1(KPARG, smem0, HSM));   GRID_SYNC(); TSTAMP(12);
    RUN(12, ph_ssdconv(KPARG, HSM));
    RUN(13, ph_att1(KPARG, smem0));             GRID_SYNC(); TSTAMP(14);
    RUN(14, ph_ssd1(KPARG, HSM));             GRID_SYNC(); TSTAMP(15);
    RUN(15, ph_ssd2(KPARG, HSM));             GRID_SYNC(); TSTAMP(16);
    RUN(16, ph_ssd3(KPARG, HSM));             GRID_SYNC(); TSTAMP(17);
    RUN(17, ph_outproj(KPARG, smem0, HSM, 1)); GRID_SYNC(); TSTAMP(18);
    RUN(18, ph_router(KPARG, HSM, 1));        GRID_SYNC(); TSTAMP(19);
    RUN(19, moe_g1_phase(KPARG, smem0, 1, TL)); GRID_SYNC(); TSTAMP(20);
    RUN(20, moe_g2_phase(KPARG, smem0, 1, TL)); GRID_SYNC(); TSTAMP(21);
    RUN(21, combine_phase(KPARG, smem0, 1, TL));
    TSTAMP(22);
#if !defined(HIP_EMU)
    if (TS_MASK != 0u && blockIdx.x == 0 && threadIdx.x == 0) { const unsigned long long t0_ = __builtin_amdgcn_s_memrealtime(); while (__builtin_amdgcn_s_memrealtime() - t0_ < ts_acc) __builtin_amdgcn_s_sleep(8); }
#endif
}

extern "C" void kernel_launch(void* const* d_in, const int* in_sizes, int n_in, void* d_out, int out_size, void* d_ws, size_t ws_size, hipStream_t stream) {
    if (n_in != N_IN || ws_size < WS_TOTAL) { fprintf(stderr, "kernel_launch: bad args n_in=%d ws=%zu need %zu\n", n_in, ws_size, (size_t)WS_TOTAL); return; }
    Params p{};
    for (int i = 0; i < N_IN; ++i) p.in[i] = (const float*)d_in[i];
    p.out = (float*)d_out; p.ws = (char*)d_ws;
    (void)hipMemsetAsync(d_ws, 0, CTL_BYTES, stream);
#ifdef HIP_EMU
    int grid = 8; if (getenv("EMU_GRID")) grid = atoi(getenv("EMU_GRID"));
    emu_launch(mega, dim3(grid), dim3(512), SMEM_BYTES, p);
#else
    static int grid = 0;
    if (!grid) { int dev = 0, cus = 0, per_cu = 0; hipGetDevice(&dev); hipDeviceGetAttribute(&cus, hipDeviceAttributeMultiprocessorCount, dev);
        hipOccupancyMaxActiveBlocksPerMultiprocessor(&per_cu, mega, 512, 0); if (per_cu > 1) per_cu = 1; if (per_cu < 1) per_cu = 1; grid = cus * per_cu; }
    void* args[] = {&p};
    hipError_t e = hipLaunchCooperativeKernel((void*)mega, dim3(grid), dim3(512), args, 0, stream);
    if (e != hipSuccess) fprintf(stderr, "cooperative launch failed: %s (grid %d)\n", hipGetErrorString(e), grid);
#endif
}

#ifdef HIP_EMU
extern "C" void emu_cmp(const char* name, const void* ptr, int rows, int cols, int ld, int is_bf16);
extern "C" void emu_debug_compare(void* d_ws) {
    char* ws = (char*)d_ws;
    emu_cmp("L1_mod", ws + WS_MOD + (size_t)NR * NMOD * DM * 4, NR, NMOD * DM, NMOD * DM, 0);
    emu_cmp("L1_h", ws + WS_HB, TL, DM, DM, 1);
    emu_cmp("L1_cat", ws + WS_CAT, TL, 1024, LDC, 1);
    emu_cmp("L1_x1", ws + WS_X, TL, DM, DM, 1);
}
#endif
```
